# Optimizing an MI355X kernel written in HIP

```python
import math
import jax
import jax.numpy as jnp
from jax import lax
import numpy as np

D_MODEL = 1024
BATCH = 8
SEQ = 4096
DEPTH = 2

GRID_W = 64
CTX_LEN = 256
EPS = 1e-6
D_RNN = 1024
RNN_BLOCKS = 8
RNN_BW = D_RNN // RNN_BLOCKS
CONV_W = 4
CONV_LEFT = 2
LRU_C = 8.0
N_HEADS = 8
HEAD_DIM = 64
V_DIM = 2 * HEAD_DIM
ATTN_QK = N_HEADS * 2 * HEAD_DIM
ATTN_V = N_HEADS * V_DIM
Q_BLOCK = 128
ROPE_BASE = 10000.0
N_EXPERTS = 16
N_GROUPS = 4
EXPERTS_PER_GROUP = N_EXPERTS // N_GROUPS
TOP_K = 2
D_EXPERT = 1024
MOE_BLOCK = 256
COL_SPLITS = (D_RNN, ATTN_QK, ATTN_V, ATTN_QK, D_RNN, D_MODEL, D_MODEL)
D_IN = sum(COL_SPLITS)
CTX_LAST_PARTS = 3

kernel_name = 'hybrid_rglru_diffattn_groupmoe_dit'


def _rmsnorm(x, g):
    xf = x.astype(jnp.float32)
    y = xf * lax.rsqrt(jnp.mean(xf * xf, axis=-1, keepdims=True) + EPS)
    return (y * g.astype(jnp.float32)).astype(x.dtype)


def _adaln(cond, w_mod, b_mod):
    m = jax.nn.silu(cond) @ w_mod + b_mod
    return jnp.split(m, 6, axis=-1)


def _modulate(h, shift, scale):
    return h * (1 + scale) + shift


def _split_proj(p, n_parts):
    idx, acc = [], 0
    for s in COL_SPLITS[:n_parts - 1]:
        acc += s
        idx.append(acc)
    return jnp.split(p, idx, axis=-1)


def _axial_rope_tables(rows, dtype):
    n_pairs = HEAD_DIM // 4
    inv = ROPE_BASE ** (-jnp.arange(n_pairs, dtype=jnp.float32) / n_pairs)
    r = jnp.repeat(jnp.arange(rows, dtype=jnp.float32), GRID_W)
    col = jnp.tile(jnp.arange(GRID_W, dtype=jnp.float32), rows)
    ang = jnp.concatenate([r[:, None] * inv, col[:, None] * inv], axis=-1)
    return jnp.cos(ang).astype(dtype), jnp.sin(ang).astype(dtype)


def _apply_rope(t, cos, sin):
    tp = t.reshape(t.shape[:-1] + (HEAD_DIM // 2, 2))
    t1, t2 = tp[..., 0], tp[..., 1]
    cs = cos[None, :, None, None, :]
    sn = sin[None, :, None, None, :]
    return jnp.stack([t1 * cs - t2 * sn, t1 * sn + t2 * cs], axis=-1).reshape(t.shape)


def _centred_dwconv(u, w, b):
    L = u.shape[1]
    up = jnp.pad(u, ((0, 0), (CONV_LEFT, CONV_W - 1 - CONV_LEFT), (0, 0)))
    out = b
    for j in range(CONV_W):
        out = out + up[:, j:j + L] * w[j]
    return out


def _block_diag(u, w, b):
    ub = u.reshape(u.shape[:-1] + (RNN_BLOCKS, RNN_BW))
    return jnp.einsum('blni,nio->blno', ub, w).reshape(u.shape) + b


def _lin_combine(left, right):
    a_l, b_l = left
    a_r, b_r = right
    return a_l * a_r, a_r * b_l + b_r


def _rglru_scan(u, h0, w_a, b_a, w_x, b_x, lam):
    r = jax.nn.sigmoid(_block_diag(u, w_a, b_a).astype(jnp.float32))
    i = jax.nn.sigmoid(_block_diag(u, w_x, b_x).astype(jnp.float32))
    log_a = -LRU_C * r * jax.nn.softplus(-lam.astype(jnp.float32))
    a = jnp.exp(log_a)
    b = jnp.sqrt(-jnp.expm1(2.0 * log_a)) * i * u.astype(jnp.float32)
    b = b.at[:, 0].add(a[:, 0] * h0)
    _, h = lax.associative_scan(_lin_combine, (a, b), axis=1)
    return h


def _bidir_rglru(u_c, u_l, w_a, b_a, w_x, b_x, lam, with_ctx):
    h0 = jnp.zeros((u_l.shape[0], D_RNN), jnp.float32)
    hc_f = _rglru_scan(u_c, h0, w_a[0], b_a[0], w_x[0], b_x[0], lam[0])
    hl_f = _rglru_scan(u_l, hc_f[:, -1], w_a[0], b_a[0], w_x[0], b_x[0], lam[0])
    hc_b = _rglru_scan(jnp.flip(u_c, 1), h0, w_a[1], b_a[1], w_x[1], b_x[1], lam[1])
    hl_b = _rglru_scan(jnp.flip(u_l, 1), hc_b[:, -1], w_a[1], b_a[1], w_x[1], b_x[1], lam[1])
    y_l = (hl_f + jnp.flip(hl_b, 1)).astype(u_l.dtype)
    y_c = (hc_f + jnp.flip(hc_b, 1)).astype(u_c.dtype) if with_ctx else None
    return y_l, y_c


def _diff_attend(q, k, v, lam):
    s = jnp.einsum('bqhcd,bkhcd->bhcqk', q, k, preferred_element_type=jnp.float32) * (HEAD_DIM ** -0.5)
    p = jax.nn.softmax(s, axis=-1)
    p = p[:, :, 0] - lam * p[:, :, 1]
    return jnp.einsum('bhqk,bkhe->bqhe', p.astype(v.dtype), v)


def _latent_diff_attention(q, k_all, v_all, lam):
    B, S = q.shape[:2]
    nb = S // Q_BLOCK
    qb = jnp.moveaxis(q.reshape((B, nb, Q_BLOCK) + q.shape[2:]), 1, 0)
    ob = lax.map(lambda qi: _diff_attend(qi, k_all, v_all, lam), qb)
    return jnp.moveaxis(ob, 0, 1).reshape(B, S, N_HEADS, V_DIM)


def _moe(h, w_router, b_router, w1, w3, w2):
    T, D = h.shape
    logits = jnp.matmul(h, w_router).astype(jnp.float32) + b_router.astype(jnp.float32)
    probs = jax.nn.softmax(logits, axis=-1).reshape(T, N_GROUPS, EXPERTS_PER_GROUP)
    group = jnp.argmax(probs.max(axis=-1), axis=-1)
    in_group = jnp.take_along_axis(probs, group[:, None, None], axis=1)[:, 0]
    top_p, top_local = lax.top_k(in_group, TOP_K)
    expert = (group[:, None] * EXPERTS_PER_GROUP + top_local).reshape(-1).astype(jnp.int32)
    gate = (top_p / jnp.sum(top_p, axis=-1, keepdims=True)).reshape(-1)
    A = T * TOP_K
    order = jnp.argsort(expert)
    sorted_e = expert[order]
    sizes = jnp.bincount(expert, length=N_EXPERTS)
    padded = (sizes + MOE_BLOCK - 1) // MOE_BLOCK * MOE_BLOCK
    starts = jnp.cumsum(sizes) - sizes
    pend = jnp.cumsum(padded)
    pstarts = pend - padded
    dest = pstarts[sorted_e] + jnp.arange(A) - starts[sorted_e]
    n_blocks = -(-A // MOE_BLOCK) + N_EXPERTS
    n_slots = n_blocks * MOE_BLOCK
    slot_tok = jnp.full((n_slots,), T, jnp.int32).at[dest].set((order // TOP_K).astype(jnp.int32))
    slot_gate = jnp.zeros((n_slots,), jnp.float32).at[dest].set(gate[order])
    block_e = jnp.minimum(jnp.searchsorted(pend, jnp.arange(n_blocks) * MOE_BLOCK, side='right'), N_EXPERTS - 1)
    h_pad = jnp.concatenate([h, jnp.zeros((1, D), h.dtype)], axis=0)
    xb = h_pad[slot_tok].reshape(n_blocks, MOE_BLOCK, D)

    def expert_block(args):
        xe, e = args
        return (jax.nn.silu(xe @ w1[e]) * (xe @ w3[e])) @ w2[e]

    yb = lax.map(expert_block, (xb, block_e)).reshape(n_slots, D)
    y = yb * slot_gate[:, None].astype(yb.dtype)
    return jnp.zeros((T + 1, D), h.dtype).at[slot_tok].add(y)[:T]


def setup_inputs(seed: int = 0) -> dict:
    key = jax.random.key(seed)
    ks = jax.random.split(key, 32)
    f32 = jnp.float32
    D = D_MODEL

    def nrm(k, shape, s):
        return jax.random.normal(k, shape, f32) * s

    a8 = jax.random.uniform(ks[15], (DEPTH, 2, D_RNN), f32, 0.9, 0.999)
    a = a8 ** (1.0 / LRU_C)
    return {
        'x': nrm(ks[0], (BATCH, SEQ, D), 1.0),
        'c': nrm(ks[1], (BATCH, D), 1.0),
        'ctx': nrm(ks[2], (BATCH, CTX_LEN, D), 1.0),
        'c_ctx': nrm(ks[3], (D,), 1.0),
        'w_mod': nrm(ks[4], (DEPTH, D, 6 * D), 0.5 * D ** -0.5),
        'b_mod': nrm(ks[5], (DEPTH, 6 * D), 0.02),
        'g_norm1': 1.0 + nrm(ks[6], (DEPTH, D), 0.02),
        'g_norm2': 1.0 + nrm(ks[7], (DEPTH, D), 0.02),
        'w_in': nrm(ks[8], (DEPTH, D, D_IN), D ** -0.5),
        'conv_w': nrm(ks[9], (DEPTH, CONV_W, D_RNN), CONV_W ** -0.5),
        'conv_b': nrm(ks[10], (DEPTH, D_RNN), 0.02),
        'lru_wa': nrm(ks[11], (DEPTH, 2, RNN_BLOCKS, RNN_BW, RNN_BW), RNN_BW ** -0.5),
        'lru_ba': nrm(ks[12], (DEPTH, 2, D_RNN), 0.02),
        'lru_wx': nrm(ks[13], (DEPTH, 2, RNN_BLOCKS, RNN_BW, RNN_BW), RNN_BW ** -0.5),
        'lru_bx': nrm(ks[14], (DEPTH, 2, D_RNN), 0.02),
        'lru_lambda': jnp.log(a) - jnp.log1p(-a),
        'diff_lambda': nrm(ks[16], (DEPTH, 4, HEAD_DIM), 0.1),
        'g_subln': 1.0 + nrm(ks[17], (DEPTH, V_DIM), 0.02),
        'w_rnn_proj': nrm(ks[18], (DEPTH, D_RNN, D), D_RNN ** -0.5),
        'w_attn_proj': nrm(ks[19], (DEPTH, ATTN_V, D), ATTN_V ** -0.5),
        'w_o': nrm(ks[20], (DEPTH, D, D), D ** -0.5),
        'w_router': nrm(ks[21], (D, N_EXPERTS), D ** -0.5),
        'b_router': nrm(ks[22], (N_EXPERTS,), 0.01),
        'w_e1': nrm(ks[23], (DEPTH, N_EXPERTS, D, D_EXPERT), D ** -0.5),
        'w_e3': nrm(ks[24], (DEPTH, N_EXPERTS, D, D_EXPERT), D ** -0.5),
        'w_e2': nrm(ks[25], (DEPTH, N_EXPERTS, D_EXPERT, D), D_EXPERT ** -0.5),
        'g_final': 1.0 + nrm(ks[26], (D,), 0.02),
    }


def reference(x, c, ctx, c_ctx, w_mod, b_mod, g_norm1, g_norm2, w_in, conv_w, conv_b,
              lru_wa, lru_ba, lru_wx, lru_bx, lru_lambda, diff_lambda, g_subln,
              w_rnn_proj, w_attn_proj, w_o, w_router, b_router, w_e1, w_e3, w_e2, g_final):
    B, S, D = x.shape
    Lc = ctx.shape[1]
    rows = S // GRID_W
    cos, sin = _axial_rope_tables(rows, x.dtype)

    def head5(t):
        return t.reshape(t.shape[:2] + (N_HEADS, 2, HEAD_DIM))

    def headv(t):
        return t.reshape(t.shape[:2] + (N_HEADS, V_DIM))

    xc = ctx
    for l in range(DEPTH):
        last = l == DEPTH - 1
        lam_init = 0.8 - 0.6 * math.exp(-0.3 * l)
        sh1, sc1, gt1, sh2, sc2, gt2 = [m[:, None, :] for m in _adaln(c, w_mod[l], b_mod[l])]
        csh1, csc1, cgt1, csh2, csc2, cgt2 = _adaln(c_ctx, w_mod[l], b_mod[l])

        h = _modulate(_rmsnorm(x, g_norm1[l]), sh1, sc1)
        hc = _modulate(_rmsnorm(xc, g_norm1[l]), csh1, csc1)
        rx, k, v, q, rg, g_r, g_a = _split_proj(h @ w_in[l], 7)
        n_ctx_parts = CTX_LAST_PARTS if last else 7
        ctx_parts = _split_proj(hc @ w_in[l][:, :sum(COL_SPLITS[:n_ctx_parts])], n_ctx_parts)
        rx_c, k_c, v_c = ctx_parts[0], ctx_parts[1], ctx_parts[2]

        lq1, lk1, lq2, lk2 = diff_lambda[l].astype(jnp.float32)
        lam = jnp.exp(jnp.sum(lq1 * lk1)) - jnp.exp(jnp.sum(lq2 * lk2)) + lam_init
        q_l = _apply_rope(head5(q), cos, sin)
        k_l = _apply_rope(head5(k), cos, sin)
        k_c5 = head5(k_c)
        v_c4 = headv(v_c)
        k_all = jnp.concatenate([k_c5, k_l], axis=1)
        v_all = jnp.concatenate([v_c4, headv(v)], axis=1)
        o_a = _latent_diff_attention(q_l, k_all, v_all, lam)
        o_a = (_rmsnorm(o_a, g_subln[l]) * (1.0 - lam_init)).reshape(B, S, ATTN_V) @ w_attn_proj[l]

        u_l = _centred_dwconv(rx, conv_w[l], conv_b[l])
        u_c = _centred_dwconv(rx_c, conv_w[l], conv_b[l])
        y_l, y_c = _bidir_rglru(u_c, u_l, lru_wa[l], lru_ba[l], lru_wx[l], lru_bx[l], lru_lambda[l], not last)
        o_r = (y_l * jax.nn.gelu(rg)) @ w_rnn_proj[l]

        x = x + gt1 * ((jax.nn.sigmoid(g_r) * o_r + jax.nn.sigmoid(g_a) * o_a) @ w_o[l])
        if not last:
            q_c, rg_c, g_r_c, g_a_c = ctx_parts[3], ctx_parts[4], ctx_parts[5], ctx_parts[6]
            o_ac = _diff_attend(head5(q_c), k_c5, v_c4, lam)
            o_ac = (_rmsnorm(o_ac, g_subln[l]) * (1.0 - lam_init)).reshape(B, Lc, ATTN_V) @ w_attn_proj[l]
            o_rc = (y_c * jax.nn.gelu(rg_c)) @ w_rnn_proj[l]
            xc = xc + cgt1 * ((jax.nn.sigmoid(g_r_c) * o_rc + jax.nn.sigmoid(g_a_c) * o_ac) @ w_o[l])

        h2 = _modulate(_rmsnorm(x, g_norm2[l]), sh2, sc2).reshape(B * S, D)
        if not last:
            h2c = _modulate(_rmsnorm(xc, g_norm2[l]), csh2, csc2).reshape(B * Lc, D)
            y = _moe(jnp.concatenate([h2, h2c], axis=0), w_router, b_router, w_e1[l], w_e3[l], w_e2[l])
            xc = xc + cgt2 * y[B * S:].reshape(B, Lc, D)
            y_lat = y[:B * S]
        else:
            y_lat = _moe(h2, w_router, b_router, w_e1[l], w_e3[l], w_e2[l])
        x = x + gt2 * y_lat.reshape(B, S, D)

    return _rmsnorm(x, g_final)
```

```cpp
#include <hip/hip_runtime.h>
#include <cstdio>
#include <cstdint>

#ifndef MK_PER_PHASE
#define MK_PER_PHASE 0
#endif

#ifndef MK_VERIFY
#define MK_VERIFY 0
#endif
#ifndef MK_VCHECK
#define MK_VCHECK 0
#endif
#ifndef ATT_PRIO
#define ATT_PRIO 0
#endif
#ifndef ATT_VAR
#define ATT_VAR 0
#endif
#define GAS __attribute__((address_space(1)))
#define LAS __attribute__((address_space(3)))
typedef short s16x4 __attribute__((ext_vector_type(4)));
typedef float f32x16 __attribute__((ext_vector_type(16)));
typedef unsigned u32x2 __attribute__((ext_vector_type(2)));

namespace pg8 {
#define PG8_LAS __attribute__((address_space(3)))
typedef unsigned short bf16_t;
typedef short bf16x8 __attribute__((ext_vector_type(8)));
typedef float f32x4 __attribute__((ext_vector_type(4)));
typedef unsigned u32x4 __attribute__((ext_vector_type(4)));
typedef float f32x2 __attribute__((ext_vector_type(2)));
constexpr int BM = 256, BK = 64, HALF = 128, HTB = HALF * BK * 2  , STAGE_BYTES = 8 * HTB, NXCD = 8, WGM = 8;

__host__ __device__ __forceinline__ int lds_byte(int r, int c) { const int st = (r >> 4) * 2 + (c >> 5), rr = r & 15, cc = c & 31, ob = rr * 64 + cc * 2; return st * 1024 + (ob ^ (((ob >> 9) & 1) << 5)); }
__host__ __device__ __forceinline__ void stage_rc(int b, int& R, int& C) { const int st = b / 1024, sb = b % 1024, swz = sb ^ (((sb >> 9) & 1) << 5); R = (st >> 1) * 16 + swz / 64; C = (st & 1) * 32 + (swz % 64) / 2; }
__host__ __device__ __forceinline__ int perm32(int rho) { const int n = rho >> 4, i = rho & 15; return 8 * (i >> 2) + 4 * n + (i & 3); }

struct Unit { int pm, pn, pa, pb, sub; };
struct Gemm { const bf16_t* A; const bf16_t* Bt; int K; };

struct StaticOrder {
    int nM, nN, nwg, G, c;
    __host__ __device__ void init(int M, int N, int G_, int c_) { nM = M / BM; nN = N / BM; nwg = nM * nN; G = G_; c = c_; }
    __host__ __device__ bool next(int i, Unit& u) const {
        const long L = (long)i * G + c; if (L >= nwg) return false;
        int wgid = (int)L; { const int q = nwg / NXCD, r = nwg % NXCD, xcd = wgid % NXCD, off = wgid / NXCD; wgid = (xcd < r ? xcd * (q + 1) : r * (q + 1) + (xcd - r) * q) + off; }
        const int nig = WGM * nN, gid = wgid / nig, fm = gid * WGM, gsz = (nM - fm) < WGM ? (nM - fm) : WGM;
        u.pm = fm + ((wgid % nig) % gsz); u.pn = (wgid % nig) / gsz; u.pa = u.pm; u.pb = u.pn; u.sub = 0; return true;
    }
    __device__ __forceinline__ void a_ready(const Unit&) const {}
    __device__ __forceinline__ void done(const Unit&) const {}
};

__device__ __forceinline__ unsigned cvt_pk_bf16(float lo, float hi) { unsigned r; asm volatile("v_cvt_pk_bf16_f32 %0, %1, %2" : "=v"(r) : "v"(lo), "v"(hi)); return r; }

template <class Epi, class Sched, bool ALIGN_EPI = false, bool SP2 = false, bool F8 = false>
__device__ __forceinline__ void gemm_phase(PG8_LAS unsigned char* lds, const Gemm g, const Sched& S, const Epi& E, const int tid  ) {
    const int wid = __builtin_amdgcn_readfirstlane(tid >> 6), lane = tid & 63, wr = wid >> 2, wc = wid & 3, fr = lane & 15, fq = lane >> 4;
    const int K = g.K, nt = K / BK;
    unsigned voffA[2], voffB[2];
#pragma unroll
    for (int i = 0; i < 2; ++i) { int R, C; stage_rc(tid * 16 + i * 8192, R, C); const int Rb = Epi::PERM ? ((R & ~31) + perm32(R & 31)) : R;
        voffA[i] = (unsigned)(R * K + C) * 2u; voffB[i] = (unsigned)(Rb * K + C) * 2u; }
    const size_t kstep = (size_t)(BK * 2);
    const size_t hstep = (size_t)HALF * K * 2;
    const size_t tstep = 2 * hstep;
    const unsigned ldsw = (unsigned)wid * 1024u;
    const int aoff = lds_byte(wr * 64 + fr, fq * 8), boff = lds_byte(wc * 32 + fr, fq * 8);
#define PG8_SA(b, h) (((b) * 2 + (h)) * HTB)
#define PG8_SB(b, h) ((4 + (b) * 2 + (h)) * HTB)
#define PG8_STAGE(bufoff, gbase, voff) do { _Pragma("unroll") for (int _i = 0; _i < 2; ++_i) \
        __builtin_amdgcn_global_load_lds((const unsigned*)((const char*)(gbase) + (voff)[_i]), (PG8_LAS unsigned*)(lds + (bufoff) + ldsw + _i * 8192), 16, 0, 0); } while (0)
#define PG8_LD8(addr) __builtin_shufflevector(*(const PG8_LAS i32x4_*)(addr), *(const PG8_LAS i32x4_*)((addr) + 1024), 0, 1, 2, 3, 4, 5, 6, 7)
#define PG8_LDA(dst, b, h) do { if constexpr (F8) { _Pragma("unroll") for (int m = 0; m < 4; ++m) dst##8[m] = PG8_LD8(lds + PG8_SA(b, h) + aoff + m * 2048); } \
        else { _Pragma("unroll") for (int m = 0; m < 4; ++m) _Pragma("unroll") for (int k = 0; k < 2; ++k) dst[m][k] = *(const PG8_LAS bf16x8*)(lds + PG8_SA(b, h) + aoff + m * 2048 + k * 1024); } } while (0)
#define PG8_LDB(dst, b, h) do { if constexpr (F8) { _Pragma("unroll") for (int n = 0; n < 2; ++n) dst##8[n] = PG8_LD8(lds + PG8_SB(b, h) + boff + n * 2048); } \
        else { _Pragma("unroll") for (int n = 0; n < 2; ++n) _Pragma("unroll") for (int k = 0; k < 2; ++k) dst[n][k] = *(const PG8_LAS bf16x8*)(lds + PG8_SB(b, h) + boff + n * 2048 + k * 1024); } } while (0)
#define PG8_MMA(ai, bj, At, Bt) do { __builtin_amdgcn_s_setprio(1); _Pragma("unroll") for (int m = 0; m < 4; ++m) _Pragma("unroll") for (int n = 0; n < 2; ++n) { \
        if constexpr (F8) asm volatile("v_mfma_f32_16x16x128_f8f6f4 %0, %1, %2, %0" : "+v"(acc[ai][bj][m][n]) : "v"(Bt##8[n]), "v"(At##8[m]));     \
        else { _Pragma("unroll") for (int k = 0; k < 2; ++k) acc[ai][bj][m][n] = __builtin_amdgcn_mfma_f32_16x16x32_bf16(Bt[n][k], At[m][k], acc[ai][bj][m][n], 0, 0, 0); } } \
        __builtin_amdgcn_s_setprio(0); } while (0)
#define PG8_WAIT_V(n) asm volatile("s_waitcnt vmcnt(" #n ")" ::: "memory")
#define PG8_WAIT_L(n) asm volatile("s_waitcnt lgkmcnt(" #n ")" ::: "memory")
#define PG8_BAR __builtin_amdgcn_s_barrier()
#define PG8_SCHED __builtin_amdgcn_sched_barrier(0)
    Unit cur, nxt; int ui = 0;
    if (!S.next(0, cur)) return;
    float zf_ = 0.f; asm volatile("" : "+v"(zf_));
    f32x4 acc[2][2][4][2];
#pragma unroll
    for (int a = 0; a < 2; ++a)
#pragma unroll
        for (int b = 0; b < 2; ++b)
#pragma unroll
            for (int m = 0; m < 4; ++m)
#pragma unroll
                for (int n = 0; n < 2; ++n) acc[a][b][m][n] = (f32x4){zf_, zf_, zf_, zf_};
    typedef int i32x4_ __attribute__((ext_vector_type(4))); typedef int i32x8_ __attribute__((ext_vector_type(8)));
    bf16x8 At[4][2], B0[2][2], B1[2][2];
    i32x8_ At8[4], B08[2], B18[2];
    const char* cA = (const char*)g.A + (size_t)cur.pa * tstep; const char* cB = (const char*)g.Bt + (size_t)cur.pb * tstep;
    S.a_ready(cur);
    if constexpr (SP2) {
        PG8_STAGE(PG8_SB(0, 0), cB, voffB); PG8_STAGE(PG8_SB(0, 1), cB + hstep, voffB); PG8_STAGE(PG8_SA(0, 0), cA, voffA); PG8_STAGE(PG8_SA(0, 1), cA + hstep, voffA);
        if (wr == 1) PG8_BAR;
        PG8_WAIT_V(2); PG8_BAR;
        PG8_STAGE(PG8_SB(1, 0), cB + kstep, voffB); PG8_STAGE(PG8_SA(1, 0), cA + kstep, voffA); PG8_STAGE(PG8_SB(1, 1), cB + hstep + kstep, voffB);
        PG8_WAIT_V(6); PG8_BAR;
    } else {
        PG8_STAGE(PG8_SB(0, 0), cB, voffB); PG8_STAGE(PG8_SA(0, 0), cA, voffA); PG8_STAGE(PG8_SB(0, 1), cB + hstep, voffB); PG8_STAGE(PG8_SA(0, 1), cA + hstep, voffA);
        if (wr == 1) PG8_BAR;
        PG8_WAIT_V(4); PG8_BAR;
        PG8_STAGE(PG8_SB(1, 0), cB + kstep, voffB); PG8_STAGE(PG8_SA(1, 0), cA + kstep, voffA); PG8_STAGE(PG8_SB(1, 1), cB + hstep + kstep, voffB);
        PG8_WAIT_V(6); PG8_BAR;
    }
    for (;;) {
        const bool has_next = S.next(ui + 1, nxt);
        const char* nA = has_next ? (const char*)g.A + (size_t)nxt.pa * tstep : cA; const char* nB = has_next ? (const char*)g.Bt + (size_t)nxt.pb * tstep : cB;
#pragma nounroll
        for (int t = 0; t < nt; t += 2) {
            const bool last = (t == nt - 2);
            const char* a1 = cA + (size_t)(t + 1) * kstep;
            const char* a2 = last ? nA : cA + (size_t)(t + 2) * kstep; const char* b2 = last ? nB : cB + (size_t)(t + 2) * kstep;
            const char* a3 = a2 + kstep; const char* b3 = b2 + kstep;
            if (last && has_next) S.a_ready(nxt);
            if constexpr (SP2) {
            PG8_LDB(B0, 0, 0); PG8_LDB(B1, 0, 1); PG8_SCHED; PG8_LDA(At, 0, 0); PG8_STAGE(PG8_SA(1, 1), a1 + hstep, voffA);
            PG8_WAIT_V(8); PG8_WAIT_L(0); PG8_BAR; PG8_MMA(0, 0, At, B0); PG8_MMA(0, 1, At, B1); PG8_BAR; PG8_SCHED;
            PG8_LDA(At, 0, 1); PG8_STAGE(PG8_SB(0, 0), b2, voffB); PG8_STAGE(PG8_SB(0, 1), b2 + hstep, voffB); PG8_STAGE(PG8_SA(0, 0), a2, voffA);
            PG8_WAIT_V(8); PG8_WAIT_L(0); PG8_BAR; PG8_MMA(1, 0, At, B0); PG8_MMA(1, 1, At, B1); PG8_BAR; PG8_SCHED;
            PG8_LDB(B0, 1, 0); PG8_LDB(B1, 1, 1); PG8_SCHED; PG8_LDA(At, 1, 0); PG8_STAGE(PG8_SA(0, 1), a2 + hstep, voffA);
            PG8_WAIT_V(8); PG8_WAIT_L(0); PG8_BAR; PG8_MMA(0, 0, At, B0); PG8_MMA(0, 1, At, B1); PG8_BAR; PG8_SCHED;
            PG8_LDA(At, 1, 1); PG8_STAGE(PG8_SB(1, 0), b3, voffB); PG8_STAGE(PG8_SB(1, 1), b3 + hstep, voffB); PG8_STAGE(PG8_SA(1, 0), a3, voffA);
            PG8_WAIT_V(8); PG8_WAIT_L(0); PG8_BAR; PG8_MMA(1, 0, At, B0); PG8_MMA(1, 1, At, B1); PG8_BAR; PG8_SCHED;
            } else {
            PG8_LDB(B0, 0, 0); PG8_SCHED; PG8_LDA(At, 0, 0); PG8_STAGE(PG8_SA(1, 1), a1 + hstep, voffA);
            PG8_WAIT_L(8); PG8_BAR; PG8_WAIT_L(0); PG8_MMA(0, 0, At, B0); PG8_BAR; PG8_SCHED;
            PG8_LDB(B1, 0, 1); PG8_STAGE(PG8_SB(0, 0), b2, voffB);
            PG8_BAR; PG8_WAIT_L(0); PG8_MMA(0, 1, At, B1); PG8_BAR;
            PG8_LDA(At, 0, 1); PG8_STAGE(PG8_SA(0, 0), a2, voffA);
            PG8_BAR; PG8_WAIT_L(0); PG8_MMA(1, 0, At, B0); PG8_BAR; PG8_SCHED;
            PG8_STAGE(PG8_SB(0, 1), b2 + hstep, voffB);
            PG8_WAIT_V(6); PG8_BAR; PG8_MMA(1, 1, At, B1); PG8_BAR;
            PG8_LDB(B0, 1, 0); PG8_SCHED; PG8_LDA(At, 1, 0); PG8_STAGE(PG8_SA(0, 1), a2 + hstep, voffA);
            PG8_WAIT_L(8); PG8_BAR; PG8_WAIT_L(0); PG8_MMA(0, 0, At, B0); PG8_BAR; PG8_SCHED;
            PG8_LDB(B1, 1, 1); PG8_STAGE(PG8_SB(1, 0), b3, voffB);
            PG8_BAR; PG8_WAIT_L(0); PG8_MMA(0, 1, At, B1); PG8_BAR;
            PG8_LDA(At, 1, 1); PG8_STAGE(PG8_SA(1, 0), a3, voffA);
            PG8_BAR; PG8_WAIT_L(0); PG8_MMA(1, 0, At, B0); PG8_BAR; PG8_SCHED;
            PG8_STAGE(PG8_SB(1, 1), b3 + hstep, voffB);
            PG8_WAIT_V(6); PG8_BAR; PG8_MMA(1, 1, At, B1); PG8_BAR;
            }
        }
        if constexpr (F8) asm volatile("s_nop 15\n\ts_nop 15" ::: "memory");
        if constexpr (ALIGN_EPI) { if (wr == 0) PG8_BAR; }
        if constexpr (!Epi::AFTER_DRAIN) { E(acc, cur, wr, wc, fr, fq); S.done(cur); }
        if (!has_next) break;
#pragma unroll
        for (int a = 0; a < 2; ++a)
#pragma unroll
            for (int b = 0; b < 2; ++b)
#pragma unroll
                for (int m = 0; m < 4; ++m)
#pragma unroll
                    for (int n = 0; n < 2; ++n) acc[a][b][m][n] = (f32x4){zf_, zf_, zf_, zf_};
        cur = nxt; cA = nA; cB = nB; ++ui;
        if constexpr (ALIGN_EPI) { if (wr == 1) PG8_BAR; }
    }
    PG8_WAIT_V(0);
    if constexpr (!ALIGN_EPI) { if (wr == 0) PG8_BAR; }
    PG8_BAR;
    if constexpr (Epi::AFTER_DRAIN) { E.fused(acc, cur, wr, wc, fr, fq, lds, wid, lane); S.done(cur); }
#undef PG8_SA
#undef PG8_SB
#undef PG8_STAGE
#undef PG8_LD8
#undef PG8_LDA
#undef PG8_LDB
#undef PG8_MMA
#undef PG8_WAIT_V
#undef PG8_WAIT_L
#undef PG8_BAR
#undef PG8_SCHED
}
}

using pg8::bf16_t; using pg8::bf16x8; using pg8::f32x4; using pg8::u32x4; using pg8::f32x2; using pg8::Unit;

#ifndef DBG_STOP_AFTER
#define DBG_STOP_AFTER 1000
#endif
#ifndef R1_GLOBAL_W
#define R1_GLOBAL_W 0
#endif
#ifndef R1_SIMPLE
#define R1_SIMPLE 0
#endif
constexpr int NB = 8, SEQ = 4096, LC = 256, DM = 1024, PBR = LC + SEQ  , TR = NB * PBR  , NTILE = TR / 256  , TPB = PBR / 256  ;
constexpr int DIN = 7168, NLAYER = 2, NEXP = 16, NWAVES = 8, NCOND = 9  , MODW = 6 * DM;
constexpr float EPSN = 1e-6f;
constexpr int N_PHASES = 2 + 9 * NLAYER;
constexpr int MAXBLK = 2 * TR / 256 + NEXP;
constexpr size_t PART_ELEMS = (size_t)TR * DM;

constexpr size_t MiB = 1u << 20;
constexpr size_t WS_CTL = 0, CTL_ZERO_BYTES = 1 * MiB;
constexpr size_t WS_MODV = 1 * MiB;
constexpr size_t WS_COS = 2 * MiB, WS_SIN = 2 * MiB + 512 * 1024;
constexpr size_t WS_LAM = 3 * MiB;
constexpr size_t WS_TOKINFO = 3 * MiB + 65536;
constexpr size_t WS_TOKSLOT = 4 * MiB;
constexpr size_t WS_CNT = 4 * MiB + 512 * 1024;
constexpr size_t WS_BLKTAB = WS_CNT + 65536;
constexpr size_t WS_TOKGATE = 5 * MiB;
constexpr size_t WS_TOKC = 5 * MiB + 512 * 1024;
constexpr size_t WS_XC = 8 * MiB;
constexpr size_t WS_WMIX = 16 * MiB, WMIX_LAYER = 21 * MiB;
constexpr size_t WM_WIN = 0, WM_WR = 14 * MiB, WM_WA = 16 * MiB, WM_WO = 18 * MiB, WM_LRU = 20 * MiB;
constexpr size_t WS_HA = 58 * MiB;
constexpr size_t WS_PARTS = 126 * MiB;
constexpr size_t WS_GATES = WS_PARTS + 5 * 68 * MiB, GATE_BYTES = (size_t)TR * DM;
constexpr size_t WS_XB = WS_PARTS, WS_ACT = WS_PARTS + 144 * MiB;
constexpr size_t WS_W13 = WS_PARTS + 6 * 68 * MiB, WS_W2 = WS_W13 + 32 * MiB;
constexpr size_t WS_END = WS_W13 + 96 * MiB;
constexpr size_t F8_TILE = 256 * (size_t)DM;
static_assert(PART_ELEMS * 2 == 68 * MiB && WS_ACT + 72 * MiB <= WS_W13 && (size_t)MAXBLK * 256 * 2048 == 144 * MiB && WS_END == 630 * MiB, "ws map");
static_assert(WS_XB % F8_TILE == 0 && WS_ACT % F8_TILE == 0 && WS_W13 % F8_TILE == 0 && WS_W2 % F8_TILE == 0, "tile-addressed regions");
constexpr int CW_TMO = 0, CW_BAR = 4096, CW_QUEUE = 8192;

constexpr int RING_BYTES = 131072, LDSCTL_OFF = RING_BYTES, MISC_OFF = LDSCTL_OFF + 320, TAB_OFF = LDSCTL_OFF + 1024, LDS_BYTES = 147456;

#define LDS_WAIT() asm volatile("s_waitcnt lgkmcnt(0)" ::: "memory")
#define VM_WAIT() asm volatile("s_waitcnt vmcnt(0)" ::: "memory")
#define SBAR() __builtin_amdgcn_sched_barrier(0)
__device__ __forceinline__ unsigned f2bf(float f) { unsigned u = __builtin_bit_cast(unsigned, f); return (u + 0x7fffu + ((u >> 16) & 1u)) >> 16; }
__device__ __forceinline__ unsigned pk2(float lo, float hi) { return f2bf(lo) | (f2bf(hi) << 16); }
__device__ __forceinline__ float bflo(unsigned w) { return __builtin_bit_cast(float, w << 16); }
__device__ __forceinline__ float bfhi(unsigned w) { return __builtin_bit_cast(float, w & 0xffff0000u); }
__device__ __forceinline__ float fast_sigmoid(float x) { return __builtin_amdgcn_rcpf(1.f + __builtin_amdgcn_exp2f(-1.4426950408889634f * x)); }
__device__ __forceinline__ float gelu_tanh(float x) { return x * fast_sigmoid(1.5957691216057308f * (x + 0.044715f * x * x * x)); }
__device__ __forceinline__ unsigned pk4_fp8(float a, float b, float c, float d) { unsigned w = 0u; w = __builtin_amdgcn_cvt_pk_fp8_f32(a, b, w, false); w = __builtin_amdgcn_cvt_pk_fp8_f32(c, d, w, true); return w; }
__device__ __forceinline__ unsigned ld_dev(const void* p) { return __hip_atomic_load((const unsigned*)p, __ATOMIC_RELAXED, __HIP_MEMORY_SCOPE_AGENT); }
__device__ __forceinline__ float ld_devf(const void* p) { return __builtin_bit_cast(float, ld_dev(p)); }
template <int CTRL, int ROW_MASK> __device__ __forceinline__ float dpp_add(float v) {
    return v + __builtin_bit_cast(float, __builtin_amdgcn_update_dpp(0, __builtin_bit_cast(int, v), CTRL, ROW_MASK, 0xF, false)); }
__device__ __forceinline__ float wave_sum(float v) {
    v = dpp_add<0xB1, 0xF>(v);
    v = dpp_add<0x4E, 0xF>(v);
    v = dpp_add<0x141, 0xF>(v);
    v = dpp_add<0x140, 0xF>(v);
    v = dpp_add<0x142, 0xA>(v);
    v = dpp_add<0x143, 0xC>(v);
    return __builtin_bit_cast(float, __builtin_amdgcn_readlane(__builtin_bit_cast(int, v), 63));
}

using pg8::cvt_pk_bf16;
constexpr float QSCALE = 0.125f * 1.4426950408889634f;
constexpr size_t WS_XBA = WS_PARTS + 238 * MiB, WS_XBB = WS_W13 + 48 * MiB;
static_assert(WS_XBA == WS_PARTS + 3 * 68 * MiB + 34 * MiB && WS_XBB + 34 * MiB <= WS_END && (size_t)(TR / 2) * DM * 2 == 34 * MiB && (TR / 2) % 256 == 0, "x bf16 halves");
__device__ __forceinline__ bf16_t* xb_row(unsigned char* ws, int R) { return (bf16_t*)(ws + (R < TR / 2 ? WS_XBA : WS_XBB)) + (size_t)(R < TR / 2 ? R : R - TR / 2) * DM; }
__device__ __forceinline__ int cond_of(int R) { const int b = R / PBR, p = R - b * PBR; return p < LC ? 8 : b; }
__device__ __forceinline__ f32x4 bf4(const u32x2 w) { return (f32x4){bflo(w.x), bfhi(w.x), bflo(w.y), bfhi(w.y)}; }
#ifndef G1_F8_PARTS
#define G1_F8_PARTS 0x6f
#endif
constexpr size_t WS_HA8 = WS_PARTS + 2 * 68 * MiB + 34 * MiB;
struct EpiG1 {
    static constexpr bool PERM = true, AFTER_DRAIN = false;
    bf16_t* parts; const float* cosT; const float* sinT; unsigned char* gates; int plain; float G1SC;
    __device__ __forceinline__ void operator()(const f32x4 (&acc)[2][2][4][2], const Unit& u, int wr, int wc, int fr, int fq) const {
        const int part = u.pn >> 2;
        bf16_t* base = parts + (size_t)part * PART_ELEMS;
        const int col0 = (u.pn & 3) * 256 + wc * 32 + 8 * fq;
        const int jt = u.pm % TPB, lrow0 = wr * 64 + fr, srow0 = (jt - 1) * 256 + lrow0;
        const size_t row0 = (size_t)u.pm * 256 + lrow0;
        const bool rope = (jt != 0) && (part == 1 || part == 3) && !plain;
        const int pair0 = (col0 & 63) >> 1;
        if (part == 2 && !plain) {
            unsigned char* vt = (unsigned char*)base + ((size_t)(u.pm / TPB) * DM + col0) * (68 * 64) + ((fr >> 2) & 1) * 32 + ((fr & 3) + 4 * (fr >> 3)) * 4;
#pragma unroll
            for (int ai = 0; ai < 2; ++ai)
#pragma unroll
                for (int bj = 0; bj < 2; ++bj) {
                    unsigned char* p = vt + (size_t)(bj * 128) * (68 * 64) + ((u.pm % TPB) * 4 + ai * 2 + wr) * 64;
#pragma unroll
                    for (int t = 0; t < 8; ++t) *(unsigned*)(p + (size_t)t * (68 * 64)) = pk4_fp8(acc[ai][bj][0][t >> 2][t & 3] * G1SC, acc[ai][bj][1][t >> 2][t & 3] * G1SC, acc[ai][bj][2][t >> 2][t & 3] * G1SC, acc[ai][bj][3][t >> 2][t & 3] * G1SC);
                }
            return;
        }
#pragma unroll
        for (int ai = 0; ai < 2; ++ai) {
            f32x4 csv[4], snv[4];
            if (rope) {
#pragma unroll
                for (int m = 0; m < 4; ++m) { const size_t to = (size_t)(srow0 + ai * 128 + m * 16) * 32 + pair0; csv[m] = *(const f32x4*)(cosT + to); snv[m] = *(const f32x4*)(sinT + to); }
            }
#pragma unroll
            for (int m = 0; m < 4; ++m) {
                const int dr = ai * 128 + m * 16;
                bf16_t* rowp = base + (row0 + dr) * DM + col0;
#pragma unroll
                for (int bj = 0; bj < 2; ++bj) {
                    f32x4 v0 = acc[ai][bj][m][0] * G1SC, v1 = acc[ai][bj][m][1] * G1SC;
                    if (rope) {
                        const f32x4 cs = csv[m], sn = snv[m];
                        v0 = (f32x4){v0[0] * cs[0] - v0[1] * sn[0], v0[0] * sn[0] + v0[1] * cs[0], v0[2] * cs[1] - v0[3] * sn[1], v0[2] * sn[1] + v0[3] * cs[1]};
                        v1 = (f32x4){v1[0] * cs[2] - v1[1] * sn[2], v1[0] * sn[2] + v1[1] * cs[2], v1[2] * cs[3] - v1[3] * sn[3], v1[2] * sn[3] + v1[3] * cs[3]};
                    } else if (plain) { if (part >= 5) continue;
                    } else if (part == 4) {
#pragma unroll
                        for (int t = 0; t < 4; ++t) { v0[t] = gelu_tanh(v0[t]); v1[t] = gelu_tanh(v1[t]); }
                    } else if (part >= 5) {
                        unsigned q[8];
#pragma unroll
                        for (int t = 0; t < 4; ++t) { q[t] = (unsigned)(fast_sigmoid(v0[t]) * 255.f + 0.5f); q[4 + t] = (unsigned)(fast_sigmoid(v1[t]) * 255.f + 0.5f); }
                        u32x2 w8; w8.x = q[0] | (q[1] << 8) | (q[2] << 16) | (q[3] << 24); w8.y = q[4] | (q[5] << 8) | (q[6] << 16) | (q[7] << 24);
                        *(u32x2*)(gates + (size_t)(part - 5) * GATE_BYTES + (row0 + dr) * DM + col0 + bj * 128) = w8;
                        continue;
                    }
                    if (part == 3) { v0 = v0 * QSCALE; v1 = v1 * QSCALE; }
                    if ((part == 1 || part == 3) && !plain) {
                        u32x2 w8; w8.x = pk4_fp8(v0[0], v0[1], v0[2], v0[3]); w8.y = pk4_fp8(v1[0], v1[1], v1[2], v1[3]);
                        *(u32x2*)((unsigned char*)(parts + PART_ELEMS) + (part == 3 ? GATE_BYTES : (size_t)0) + (row0 + dr) * DM + col0 + bj * 128) = w8;
                        continue;
                    }
                    u32x4 w; w.x = cvt_pk_bf16(v0[0], v0[1]); w.y = cvt_pk_bf16(v0[2], v0[3]); w.z = cvt_pk_bf16(v1[0], v1[1]); w.w = cvt_pk_bf16(v1[2], v1[3]);
                    *(u32x4*)(rowp + bj * 128) = w;
                }
            }
        }
    }
};
#ifndef G3_F8
#define G3_F8 0
#endif
struct EpiG2 {
    static constexpr bool PERM = true, AFTER_DRAIN = false;
    bf16_t* parts; const unsigned char* gates; float I255; unsigned char* m8;
    __device__ __forceinline__ void operator()(const f32x4 (&acc)[2][2][4][2], const Unit& u, int wr, int wc, int fr, int fq) const {
        const unsigned char* gate = gates + (size_t)u.sub * GATE_BYTES; bf16_t* mg = parts;
        const int col0 = u.pn * 256 + wc * 32 + 8 * fq; const size_t row0 = (size_t)u.pm * 256 + wr * 64 + fr;
        const unsigned smask = u.sub ? 0xffffffffu : 0u;
#pragma unroll
        for (int ai = 0; ai < 2; ++ai) {
            u32x2 g[4][2]; u32x4 t[4][2];
#pragma unroll
            for (int m = 0; m < 4; ++m)
#pragma unroll
                for (int bj = 0; bj < 2; ++bj) { const size_t off = (row0 + ai * 128 + m * 16) * DM + col0 + bj * 128;
                    g[m][bj] = *(const u32x2*)(gate + off); t[m][bj] = *(const u32x4*)(mg + off); }
#pragma unroll
            for (int m = 0; m < 4; ++m)
#pragma unroll
                for (int bj = 0; bj < 2; ++bj) { const size_t off = (row0 + ai * 128 + m * 16) * DM + col0 + bj * 128;
                    const u32x2 gg = g[m][bj]; u32x4 tt = t[m][bj]; tt.x &= smask; tt.y &= smask; tt.z &= smask; tt.w &= smask;
                    const f32x4 v0 = acc[ai][bj][m][0], v1 = acc[ai][bj][m][1];
                    const float r0 = v0[0] * ((float)(gg.x & 255u) * I255) + bflo(tt.x), r1 = v0[1] * ((float)((gg.x >> 8) & 255u) * I255) + bfhi(tt.x);
                    const float r2 = v0[2] * ((float)((gg.x >> 16) & 255u) * I255) + bflo(tt.y), r3 = v0[3] * ((float)(gg.x >> 24) * I255) + bfhi(tt.y);
                    const float r4 = v1[0] * ((float)(gg.y & 255u) * I255) + bflo(tt.z), r5 = v1[1] * ((float)((gg.y >> 8) & 255u) * I255) + bfhi(tt.z);
                    const float r6 = v1[2] * ((float)((gg.y >> 16) & 255u) * I255) + bflo(tt.w), r7 = v1[3] * ((float)(gg.y >> 24) * I255) + bfhi(tt.w);
                    if (G3_F8 && u.sub) { u32x2 w8; w8.x = pk4_fp8(r0, r1, r2, r3); w8.y = pk4_fp8(r4, r5, r6, r7); *(u32x2*)(m8 + off) = w8; }
                    else { u32x4 w; w.x = cvt_pk_bf16(r0, r1); w.y = cvt_pk_bf16(r2, r3); w.z = cvt_pk_bf16(r4, r5); w.w = cvt_pk_bf16(r6, r7);
                    *(u32x4*)(mg + off) = w; } }
            asm volatile("" ::: "memory");
        }
    }
};
struct EpiG3 {
    static constexpr bool PERM = true, AFTER_DRAIN = false;
    unsigned char* ws; const float* modl; float scale;
    __device__ __forceinline__ void operator()(const f32x4 (&acc)[2][2][4][2], const Unit& u, int wr, int wc, int fr, int fq) const {
        const int b = u.pm / TPB, jt = u.pm % TPB;
        bf16_t* xt = xb_row(ws, u.pm * 256);
        const float* gt = modl + (size_t)(jt == 0 ? 8 : b) * MODW + 2 * DM;
        const int col0 = u.pn * 256 + wc * 32 + 8 * fq, lrow0 = wr * 64 + fr;
        f32x4 gv[2][2];
#pragma unroll
        for (int bj = 0; bj < 2; ++bj)
#pragma unroll
            for (int n = 0; n < 2; ++n) gv[bj][n] = *(const f32x4*)(gt + col0 + bj * 128 + n * 4) * scale;
#pragma unroll
        for (int ai = 0; ai < 2; ++ai) {
            u32x4 xv[4][2];
#pragma unroll
            for (int m = 0; m < 4; ++m)
#pragma unroll
                for (int bj = 0; bj < 2; ++bj) xv[m][bj] = *(const u32x4*)(xt + (size_t)(lrow0 + ai * 128 + m * 16) * DM + col0 + bj * 128);
#pragma unroll
            for (int m = 0; m < 4; ++m)
#pragma unroll
                for (int bj = 0; bj < 2; ++bj) { const u32x4 x = xv[m][bj]; const f32x4 a0 = gv[bj][0] * acc[ai][bj][m][0], a1 = gv[bj][1] * acc[ai][bj][m][1];
                    u32x4 w; w.x = cvt_pk_bf16(bflo(x.x) + a0[0], bfhi(x.x) + a0[1]); w.y = cvt_pk_bf16(bflo(x.y) + a0[2], bfhi(x.y) + a0[3]);
                    w.z = cvt_pk_bf16(bflo(x.z) + a1[0], bfhi(x.z) + a1[1]); w.w = cvt_pk_bf16(bflo(x.w) + a1[2], bfhi(x.w) + a1[3]);
                    *(u32x4*)(xt + (size_t)(lrow0 + ai * 128 + m * 16) * DM + col0 + bj * 128) = w; }
            asm volatile("" ::: "memory");
        }
    }
};
constexpr float WSC = 1.f / 32.f;
struct EpiE1 {
    static constexpr bool PERM = true, AFTER_DRAIN = false;
    unsigned char* act;
    __device__ __forceinline__ void operator()(const f32x4 (&acc)[2][2][4][2], const Unit& u, int wr, int wc, int fr, int fq) const {
        const int col0 = u.pn * 128 + wc * 32 + 8 * fq; const size_t row0 = (size_t)u.pm * 256 + wr * 64 + fr;
#pragma unroll
        for (int ai = 0; ai < 2; ++ai)
#pragma unroll
            for (int m = 0; m < 4; ++m) {
                const f32x4 a0 = acc[ai][0][m][0], a1 = acc[ai][0][m][1], b0 = acc[ai][1][m][0], b1 = acc[ai][1][m][1];
                float r[8];
#pragma unroll
                for (int t = 0; t < 4; ++t) { const float x0 = a0[t] * WSC, x1 = a1[t] * WSC; r[t] = x0 * fast_sigmoid(x0) * (b0[t] * WSC); r[4 + t] = x1 * fast_sigmoid(x1) * (b1[t] * WSC); }
                u32x2 w; w.x = pk4_fp8(r[0], r[1], r[2], r[3]); w.y = pk4_fp8(r[4], r[5], r[6], r[7]);
                *(u32x2*)(act + (row0 + ai * 128 + m * 16) * DM + col0) = w;
            }
    }
};
constexpr float YSC = 8.f;
struct EpiE2 {
    static constexpr bool PERM = true, AFTER_DRAIN = false;
    unsigned char* y; int nostore;
    __device__ __forceinline__ void operator()(const f32x4 (&acc)[2][2][4][2], const Unit& u, int wr, int wc, int fr, int fq) const {
        const int col0 = u.pn * 256 + wc * 32 + 8 * fq; const size_t row0 = (size_t)u.pm * 256 + wr * 64 + fr;
#pragma unroll
        for (int ai = 0; ai < 2; ++ai)
#pragma unroll
            for (int m = 0; m < 4; ++m)
#pragma unroll
                for (int bj = 0; bj < 2; ++bj) {
                    const f32x4 v0 = acc[ai][bj][m][0] * (WSC * YSC), v1 = acc[ai][bj][m][1] * (WSC * YSC);
                    u32x2 w; w.x = pk4_fp8(v0[0], v0[1], v0[2], v0[3]); w.y = pk4_fp8(v1[0], v1[1], v1[2], v1[3]);
                    if (!nostore) *(u32x2*)(y + (row0 + ai * 128 + m * 16) * DM + col0 + bj * 128) = w; else asm volatile("" :: "v"(w));
                }
    }
};
struct OrderG2 { int G, c; bool noctx; int sub; bool f8;
    __device__ __forceinline__ bool next(int i, Unit& u) const { const int L = i * G + c; if (L >= (noctx ? NB * 16 : NTILE) * 4) return false;
        const int t = L >> 2; u.pm = noctx ? (t >> 4) * TPB + 1 + (t & 15) : t; u.pn = L & 3; u.sub = sub;
        if (f8) { u.pa = (sub ? 3 : 4) * (2 * NTILE) + u.pm; u.pb = sub * 8 + u.pn; }
        else { u.pa = (sub ? 3 : 4) * NTILE + u.pm; u.pb = sub * 4 + u.pn; } return true; }
    __device__ __forceinline__ void a_ready(const Unit&) const {}
    __device__ __forceinline__ void done(const Unit&) const {}
};
struct OrderG1 { int G, c, np; unsigned plist; bool f8;
    __device__ __forceinline__ bool next(int i, Unit& u) const { using namespace pg8;
        const int nN = 4 * np, nwg = NTILE * nN, L = i * G + c; if (L >= nwg) return false;
        int wgid = L; { const int q = nwg / NXCD, r = nwg % NXCD, xcd = wgid % NXCD, off = wgid / NXCD; wgid = (xcd < r ? xcd * (q + 1) : r * (q + 1) + (xcd - r) * q) + off; }
        const int nig = WGM * nN, gid = wgid / nig, fm = gid * WGM, gsz = (NTILE - fm) < WGM ? (NTILE - fm) : WGM;
        u.pm = fm + ((wgid % nig) % gsz); const int ps = (wgid % nig) / gsz, part = (plist >> (4 * (ps >> 2))) & 15;
        u.pn = part * 4 + (ps & 3); u.pa = u.pm; u.pb = f8 ? part * 8 + (ps & 3) : u.pn; u.sub = 0; return true; }
    __device__ __forceinline__ void a_ready(const Unit&) const {}
    __device__ __forceinline__ void done(const Unit&) const {}
};
constexpr int g1_np(unsigned m) { int n = 0; for (int p = 0; p < 7; ++p) n += (m >> p) & 1; return n; }
constexpr unsigned g1_plist(unsigned m) { unsigned l = 0; int n = 0; for (int p = 0; p < 7; ++p) if ((m >> p) & 1) { l |= (unsigned)p << (4 * n); ++n; } return l; }
struct OrderG3 { int G, c; bool noctx;
    __device__ __forceinline__ bool next(int i, Unit& u) const { const int L = i * G + c; if (L >= (noctx ? NB * 16 : NTILE) * 4) return false;
        const int t = L >> 2; u.pm = noctx ? (t >> 4) * TPB + 1 + (t & 15) : t; u.pn = L & 3; u.sub = 0; u.pa = u.pm; u.pb = u.pn; return true; }
    __device__ __forceinline__ void a_ready(const Unit&) const {}
    __device__ __forceinline__ void done(const Unit&) const {}
};
struct OrderE { int G, c, nblk, ng; const LAS int* tab; int a_t0, b_t0;
    __device__ __forceinline__ bool next(int i, Unit& u) const { const int L = i * G + c; if (L >= nblk * ng) return false;
        const int blk = L / ng, g = L - blk * ng, e = __builtin_amdgcn_readfirstlane(tab[blk]);
        u.pm = blk; u.pn = g; u.sub = 0; u.pa = a_t0 + blk; u.pb = b_t0 + e * ng + g; return true; }
    __device__ __forceinline__ void a_ready(const Unit&) const {}
    __device__ __forceinline__ void done(const Unit&) const {}
};

#define XB_TMO      128
#define XB_XCNT(j)  (256  + 64 * (j))
#define XB_XSUB(j)  (1280 + 64 * (j))
#define XB_XGEN(j)  (2304 + 64 * (j))
#define XB_TOP      3328
#define XB_TOPGEN   3392
#define XCD_BAR_WORDS 3456
#define XB_SPIN_CAP (1u << 18)

__device__ __forceinline__ unsigned xb_ld(unsigned* p)              { return __hip_atomic_load(p, __ATOMIC_RELAXED, __HIP_MEMORY_SCOPE_AGENT); }
__device__ __forceinline__ unsigned xb_add(unsigned* p, unsigned v) { return __hip_atomic_fetch_add(p, v, __ATOMIC_RELAXED, __HIP_MEMORY_SCOPE_AGENT); }
__device__ __forceinline__ unsigned xb_xcc_id() { return (unsigned)__builtin_amdgcn_s_getreg((3 << 11) | 20) & 0xFu; }
#define XB_SPIN(cond, bar) do { unsigned _sp = 0; while (cond) { __builtin_amdgcn_s_sleep(1); \
    if ((++_sp & 255u) == 0u) { if (xb_ld(&(bar)[XB_TMO])) break; if (_sp > XB_SPIN_CAP) { atomicAdd(&(bar)[XB_TMO], 1u); break; } } } } while (0)

struct XcdBarrier {
    unsigned* bar; unsigned x;
    volatile LAS unsigned* st;
};
__device__ __forceinline__ XcdBarrier xcd_barrier_post(unsigned* bar, volatile LAS unsigned* st) {
    XcdBarrier b; b.bar = bar; b.x = xb_xcc_id(); b.st = st;
    if (threadIdx.x == 0) (void)xb_add(&bar[XB_XCNT(b.x)], 1u);
    return b;
}
__device__ __forceinline__ void xcd_barrier_complete(unsigned* bar, unsigned x, unsigned& nloc, unsigned& nx) {
    const unsigned G = gridDim.x * gridDim.y * gridDim.z;
    unsigned sum, cnt, mine, sp = 0u;
    for (;;) {
        sum = 0u; cnt = 0u; mine = 0u;
#pragma unroll
        for (unsigned j = 0; j < 16; ++j) { const unsigned c = xb_ld(&bar[XB_XCNT(j)]); sum += c; cnt += (c > 0u) ? 1u : 0u; mine = (j == x) ? c : mine; }
        if (sum == G) break;
        __builtin_amdgcn_s_sleep(1);
        if ((++sp & 255u) == 0u) { if (xb_ld(&bar[XB_TMO])) break; if (sp > XB_SPIN_CAP) { atomicAdd(&bar[XB_TMO], 1u); break; } }
    }
    nloc = mine > 0u ? mine : 1u; nx = cnt > 0u ? cnt : 1u;
}
__device__ __forceinline__ void xcd_barrier(const XcdBarrier& b) {
    asm volatile("s_waitcnt vmcnt(0)" ::: "memory");
    __syncthreads();
    if (threadIdx.x == 0) {
        unsigned* bar = b.bar;
        __builtin_amdgcn_s_waitcnt(0);
        unsigned nloc = b.st[0], nx = b.st[1];
        if (nloc == 0u) { xcd_barrier_complete(bar, b.x, nloc, nx); b.st[0] = nloc; b.st[1] = nx; }
        const unsigned old = xb_add(&bar[XB_XSUB(b.x)], 1u);
        const unsigned gen = old / nloc;
        if (old + 1u == (gen + 1u) * nloc) {
            __builtin_amdgcn_fence(__ATOMIC_RELEASE, "agent");
            asm volatile("s_waitcnt vmcnt(0)" ::: "memory");
            const unsigned og = xb_add(&bar[XB_TOP], 1u);
            const unsigned tg = og / nx;
            if (og + 1u == (tg + 1u) * nx) xb_add(&bar[XB_TOPGEN], 1u);
            else XB_SPIN(xb_ld(&bar[XB_TOPGEN]) == tg, bar);
            __builtin_amdgcn_fence(__ATOMIC_ACQUIRE, "agent");
            xb_add(&bar[XB_XGEN(b.x)], 1u);
            asm volatile("s_waitcnt vmcnt(0)" ::: "memory");
        } else {
            XB_SPIN(xb_ld(&bar[XB_XGEN(b.x)]) == gen, bar);
            __builtin_amdgcn_fence(__ATOMIC_ACQUIRE, "agent");
            asm volatile("s_waitcnt vmcnt(0)" ::: "memory");
        }
    }
    __syncthreads();
}

struct Args { const float* in[27]; float* out; unsigned char* ws; int ph_lo, ph_hi; };
typedef const __attribute__((address_space(4))) Args* KArgs;
__device__ __forceinline__ KArgs kargs() { KArgs p = (KArgs)__builtin_amdgcn_kernarg_segment_ptr(); asm volatile("" : "+s"(p)); return p; }
struct Frame {
    LAS unsigned char* lds; unsigned char* ldsg;
    volatile LAS unsigned* MISC;
    unsigned* ctl; unsigned char* ws; float* out;
    int tid, lane, wave, vcu, G;
};
enum { I_X = 0, I_C, I_CTX, I_CCTX, I_WMOD, I_BMOD, I_GN1, I_GN2, I_WIN, I_CONVW, I_CONVB, I_LWA, I_LBA, I_LWX, I_LBX, I_LLAM, I_DLAM, I_GSUB, I_WRNN, I_WATT, I_WO, I_WROUT, I_BROUT, I_WE1, I_WE3, I_WE2, I_GFIN };

struct TrRegs { f32x4 v[8]; };
__device__ __forceinline__ void tr_load(TrRegs& t, const float* W, int N, int k0, int n0, int lane) {
#pragma unroll
    for (int i = 0; i < 8; ++i) t.v[i] = *(const f32x4*)(W + (size_t)(k0 + 8 * i + (lane >> 3)) * N + n0 + 4 * (lane & 7));
}
template <bool F8> __device__ __forceinline__ void tr_store(const TrRegs& t, int K, int k0, void* WTrow0, LAS float* scr, int lane) {
    constexpr float sc = F8 ? 32.f : 1.f;
#pragma unroll
    for (int i = 0; i < 8; ++i) { LAS float* d = scr + (8 * i + (lane >> 3)) * 33 + 4 * (lane & 7); d[0] = t.v[i][0] * sc; d[1] = t.v[i][1] * sc; d[2] = t.v[i][2] * sc; d[3] = t.v[i][3] * sc; }
    LDS_WAIT(); asm volatile("" ::: "memory");
    const int c = lane & 7;
#pragma unroll
    for (int j = 0; j < 4; ++j) { const int n = (lane >> 3) + 8 * j; const LAS float* s = scr + (8 * c) * 33 + n;
        if constexpr (F8) { u32x2 o; o.x = pk4_fp8(s[0 * 33], s[1 * 33], s[2 * 33], s[3 * 33]); o.y = pk4_fp8(s[4 * 33], s[5 * 33], s[6 * 33], s[7 * 33]);
            *(u32x2*)((unsigned char*)WTrow0 + (size_t)n * K + k0 + 8 * c) = o; }
        else { u32x4 o; o.x = pk2(s[0 * 33], s[1 * 33]); o.y = pk2(s[2 * 33], s[3 * 33]); o.z = pk2(s[4 * 33], s[5 * 33]); o.w = pk2(s[6 * 33], s[7 * 33]);
            *(u32x4*)((bf16_t*)WTrow0 + (size_t)n * K + k0 + 8 * c) = o; } }
    LDS_WAIT(); asm volatile("" ::: "memory");
}
__device__ __forceinline__ void transpose_item(const float* W, int N, int K, int k0, int n0, bf16_t* WTrow0, LAS float* scr, int lane) { TrRegs t; tr_load(t, W, N, k0, n0, lane); tr_store<false>(t, K, k0, WTrow0, scr, lane); }
__device__ __forceinline__ void transpose_item_f8(const float* W, int N, int K, int k0, int n0, unsigned char* WTrow0, LAS float* scr, int lane) { TrRegs t; tr_load(t, W, N, k0, n0, lane); tr_store<true>(t, K, k0, WTrow0, scr, lane); }
constexpr int T_WIN = (DM / 64) * (DIN / 32), T_P = (DM / 64) * (DM / 32), T_LRU = 2 * 8 * 2 * 8, T_LAYER = T_WIN + 3 * T_P + T_LRU;
struct TrGeom { const float* W; int N, K, k0, n0; void* dst; bool f8; };
__device__ __forceinline__ TrGeom mixer_transpose_geom(const Frame& F, KArgs A, int l, int t) {
    unsigned char* wl = F.ws + WS_WMIX + (size_t)l * WMIX_LAYER; TrGeom g;
    if (t < T_WIN) { const int nblk = DIN / 32, kb = t / nblk, nb = t % nblk;
        const int part = nb >> 5;
        g.W = A->in[I_WIN] + (size_t)l * DM * DIN; g.N = DIN; g.K = DM; g.k0 = 64 * kb; g.n0 = 32 * nb; g.f8 = (G1_F8_PARTS >> part) & 1;
        g.dst = g.f8 ? (void*)(wl + WM_WIN + (size_t)part * (2 * MiB) + (size_t)(32 * nb - 1024 * part) * DM) : (void*)((bf16_t*)(wl + WM_WIN) + (size_t)(32 * nb) * DM);
        return g; }
    t -= T_WIN;
    if (t < 3 * T_P) { const int which = t / T_P, tt = t % T_P, nblk = DM / 32, kb = tt / nblk, nb = tt % nblk;
        g.W = A->in[which == 0 ? I_WRNN : (which == 1 ? I_WATT : I_WO)] + (size_t)l * DM * DM; g.N = DM; g.K = DM; g.k0 = 64 * kb; g.n0 = 32 * nb; g.f8 = (which == 1 || (which == 2 && G3_F8));
        g.dst = g.f8 ? (void*)(wl + (which == 1 ? WM_WA : WM_WO) + (size_t)(32 * nb) * DM) : (void*)((bf16_t*)(wl + (which == 0 ? WM_WR : WM_WO)) + (size_t)(32 * nb) * DM);
        return g; }
    t -= 3 * T_P;
    { const int mat = t >> 3, item = t & 7, d = mat >> 4, blk = (mat >> 1) & 7, ax = mat & 1, kb = item >> 2, nb = item & 3;
        g.W = A->in[ax ? I_LWX : I_LWA] + ((size_t)(l * 2 + d) * 8 + blk) * 128 * 128; g.N = 128; g.K = 128; g.k0 = 64 * kb; g.n0 = 32 * nb; g.f8 = false;
        g.dst = (void*)((bf16_t*)(wl + WM_LRU) + ((size_t)(d * 8 + blk) * 256 + ax * 128 + 32 * nb) * 128); }
    return g;
}
__device__ __forceinline__ void mixer_transpose_item(const Frame& F, KArgs A, int l, int t, LAS float* scr, const int lane) {
    const TrGeom g = mixer_transpose_geom(F, A, l, t); TrRegs r; tr_load(r, g.W, g.N, g.k0, g.n0, lane);
    if (g.f8) tr_store<true>(r, g.K, g.k0, g.dst, scr, lane); else tr_store<false>(r, g.K, g.k0, g.dst, scr, lane);
}
__device__ __forceinline__ void mixer_conv_unit(const Frame& F0, KArgs, int cu) {
    KArgs A = kargs(); Frame F = F0; F.ws = A->ws;
    LAS float* scr = (LAS float*)(F.lds + F.wave * 8704);
    int ln = F.lane; asm volatile("" : "+v"(ln));
    for (int j = 0; j < 6; ++j) mixer_transpose_item(F, A, 1, cu * 48 + F.wave * 6 + j, scr, ln);
    __syncthreads();
}
__device__ __forceinline__ void p0_phase(const Frame& F, KArgs A, int skip = 0) {
    LAS float* sil = (LAS float*)(F.lds + 73728);
    for (int i = F.tid; i < NCOND * DM; i += NWAVES * 64) { const int r = i >> 10, k = i & 1023; const float c = r < 8 ? A->in[I_C][r * DM + k] : A->in[I_CCTX][k]; sil[i] = c / (1.f + expf(-c)); }
    __syncthreads();
    const int gw = F.vcu * NWAVES + F.wave, NGW = F.G * NWAVES, lane = F.lane;
    constexpr int N_ADA = NLAYER * (MODW / 64);
    if (skip != 1) {   LAS float* red = (LAS float*)(F.lds + 112640);
        for (int it = F.vcu; it < N_ADA; it += F.G) {
            const int l = it / (MODW / 64), col = (it % (MODW / 64)) * 64 + lane;
            const float* w = A->in[I_WMOD] + ((size_t)l * DM + F.wave * 128) * MODW + col;
            float acc[NCOND];
#pragma unroll
            for (int q = 0; q < NCOND; ++q) acc[q] = 0.f;
#pragma unroll 16
            for (int k = 0; k < 128; ++k) { const float wv = w[(size_t)k * MODW];
#pragma unroll
                for (int q = 0; q < NCOND; ++q) acc[q] += sil[q * DM + F.wave * 128 + k] * wv; }
#pragma unroll
            for (int q = 0; q < NCOND; ++q) red[(F.wave * NCOND + q) * 64 + lane] = acc[q];
            __syncthreads();
            for (int o = F.tid; o < NCOND * 64; o += NWAVES * 64) { const int q = o >> 6, cl = o & 63; float s = 0.f;
#pragma unroll
                for (int wv = 0; wv < NWAVES; ++wv) s += red[(wv * NCOND + q) * 64 + cl];
                const int cc = (it % (MODW / 64)) * 64 + cl;
                ((float*)(F.ws + WS_MODV))[((size_t)l * NCOND + q) * MODW + cc] = s + A->in[I_BMOD][l * MODW + cc]; }
            __syncthreads();
        }
    }
    LAS float* scr = (LAS float*)(F.lds + F.wave * 8704);
    constexpr int N_TR = NLAYER * T_LAYER, N_ROPE = SEQ * 32 / 64, N_TOT = N_TR + N_ROPE + 1;
    if (skip != 2) {
        static_assert(N_TR <= 6 * 256 * NWAVES, "six items per wave");
        TrRegs tr[2]; if (gw < N_TR) { const TrGeom g = mixer_transpose_geom(F, A, gw / T_LAYER, gw % T_LAYER); tr_load(tr[0], g.W, g.N, g.k0, g.n0, lane); }
#pragma unroll
        for (int j = 0; j < 6; ++j) { const int it = gw + j * NGW, nx = it + NGW;
            if (j + 1 < 6 && nx < N_TR) { const TrGeom g = mixer_transpose_geom(F, A, nx / T_LAYER, nx % T_LAYER); tr_load(tr[(j + 1) & 1], g.W, g.N, g.k0, g.n0, lane); }
            if (it < N_TR) { const TrGeom g = mixer_transpose_geom(F, A, it / T_LAYER, it % T_LAYER);
                if (g.f8) tr_store<true>(tr[j & 1], g.K, g.k0, g.dst, scr, lane); else tr_store<false>(tr[j & 1], g.K, g.k0, g.dst, scr, lane); } }
    }
    for (int it = gw; it < N_TOT; it += NGW) {
        int r = it;
        if (r < N_TR) continue;
        r -= N_TR;
        if (r < N_ROPE) { const int idx = r * 64 + lane, s = idx >> 5, i = idx & 31, j = i & 15;
            const float inv = powf(10000.f, -(float)j / 16.f), pos = (float)(i < 16 ? (s >> 6) : (s & 63)), ang = pos * inv;
            ((float*)(F.ws + WS_COS))[idx] = cosf(ang); ((float*)(F.ws + WS_SIN))[idx] = sinf(ang); continue; }
        {
            float* lams = (float*)(F.ws + WS_LAM);
            for (int l = 0; l < NLAYER; ++l) { const float* dl = A->in[I_DLAM] + l * 256;
                const float s1 = wave_sum(dl[lane] * dl[64 + lane]), s2 = wave_sum(dl[128 + lane] * dl[192 + lane]);
                const float lam_init = 0.8f - 0.6f * expf(-0.3f * (float)l);
                if (lane == 0) { lams[l * 2] = expf(s1) - expf(s2) + lam_init; lams[l * 2 + 1] = 1.f - lam_init; } }
        }
    }
}

__device__ __forceinline__ float* xrow_ptr(const Frame& F, int R, int& cond) {
    const int b = R / PBR, p = R - b * PBR;
    if (p < LC) { cond = 8; return (float*)(F.ws + WS_XC) + ((size_t)b * LC + p) * DM; }
    cond = b; return F.out + ((size_t)b * SEQ + (p - LC)) * DM;
}
struct YRows { unsigned a[4], b[4]; float g1; bool on; };
__device__ __forceinline__ u32x4 tokc_load(const Frame& F, int R) { const unsigned* p = (const unsigned*)((const u32x4*)(F.ws + WS_TOKC) + R); u32x4 t; t.x = ld_dev(p); t.y = ld_dev(p + 1); t.z = ld_dev(p + 2); t.w = ld_dev(p + 3); return t; }
__device__ __forceinline__ void y_load(const Frame& F, const u32x4 t, YRows& y, int R) {
    y.on = t.w != 0u; y.g1 = ld_devf((const float*)(F.ws + WS_TOKGATE) + R);
    const unsigned char* y1 = F.ws + WS_XB + (size_t)(y.on ? t.x : 0u) * DM, *y2 = F.ws + WS_XB + (size_t)(y.on ? t.y : 0u) * DM;
#pragma unroll
    for (int j = 0; j < 4; ++j) { const int c = 256 * j + 4 * F.lane; y.a[j] = *(const unsigned*)(y1 + c); y.b[j] = *(const unsigned*)(y2 + c); }
}
__device__ __forceinline__ void combine_apply(const Frame& F, const YRows& y, int cond, int ylayer, f32x4 (&v)[4]) {
    if (!y.on) return;
    const float g1 = y.g1 * (1.f / YSC), g2 = (1.f - y.g1) * (1.f / YSC);
    const float* gt2 = (const float*)(F.ws + WS_MODV) + ((size_t)ylayer * NCOND + cond) * MODW + 5 * DM;
#pragma unroll
    for (int j = 0; j < 4; ++j) { const int c = 256 * j + 4 * F.lane; const int a = (int)y.a[j], b = (int)y.b[j]; const f32x4 g = *(const f32x4*)(gt2 + c);
        v[j][0] += g[0] * (g1 * __builtin_amdgcn_cvt_f32_fp8(a, 0) + g2 * __builtin_amdgcn_cvt_f32_fp8(b, 0)); v[j][1] += g[1] * (g1 * __builtin_amdgcn_cvt_f32_fp8(a, 1) + g2 * __builtin_amdgcn_cvt_f32_fp8(b, 1));
        v[j][2] += g[2] * (g1 * __builtin_amdgcn_cvt_f32_fp8(a, 2) + g2 * __builtin_amdgcn_cvt_f32_fp8(b, 2)); v[j][3] += g[3] * (g1 * __builtin_amdgcn_cvt_f32_fp8(a, 3) + g2 * __builtin_amdgcn_cvt_f32_fp8(b, 3)); }
}
__device__ __forceinline__ void n1_phase(const Frame& F, KArgs A, int l) {
    const int gw = F.vcu * NWAVES + F.wave, NGW = F.G * NWAVES, lane = F.lane;
    u32x4 tn[2];
    if (l > 0) {
#pragma unroll
        for (int u = 0; u < 2; ++u) tn[u] = tokc_load(F, (gw + u * NGW < TR) ? gw + u * NGW : gw); }
    for (int R0 = gw; R0 < TR; R0 += 2 * NGW) {
        f32x4 v[2][4]; bf16_t* xp[2]; int cond[2]; bool ok[2]; YRows y[2];
#pragma unroll
        for (int u = 0; u < 2; ++u) { const int R = R0 + u * NGW; ok[u] = R < TR; const int Rc = ok[u] ? R : R0;
            xp[u] = xb_row(F.ws, Rc); cond[u] = cond_of(Rc);
            if (l == 0) { const int b = Rc / PBR, p = Rc - b * PBR; const float* src = p < LC ? A->in[I_CTX] + ((size_t)b * LC + p) * DM : A->in[I_X] + ((size_t)b * SEQ + (p - LC)) * DM;
#pragma unroll
                for (int j = 0; j < 4; ++j) v[u][j] = *(const f32x4*)(src + 256 * j + 4 * lane); }
            else {
#pragma unroll
                for (int j = 0; j < 4; ++j) v[u][j] = bf4(*(const u32x2*)(xp[u] + 256 * j + 4 * lane)); }
        }
        f32x4 gnv[4], shv[2][4], scv[2][4];
#pragma unroll
        for (int j = 0; j < 4; ++j) { const int c = 256 * j + 4 * lane; gnv[j] = *(const f32x4*)(A->in[I_GN1] + l * DM + c);
#pragma unroll
            for (int u = 0; u < 2; ++u) { const float* md = (const float*)(F.ws + WS_MODV) + ((size_t)l * NCOND + cond[u]) * MODW; shv[u][j] = *(const f32x4*)(md + c); scv[u][j] = *(const f32x4*)(md + DM + c); } }
        if (l > 0) { u32x4 t[2];
#pragma unroll
            for (int u = 0; u < 2; ++u) t[u] = tn[u];
#pragma unroll
            for (int u = 0; u < 2; ++u) y_load(F, t[u], y[u], ok[u] ? R0 + u * NGW : R0);
            const int Rn = R0 + 2 * NGW;
            if (Rn < TR) {
#pragma unroll
                for (int u = 0; u < 2; ++u) tn[u] = tokc_load(F, (Rn + u * NGW < TR) ? Rn + u * NGW : Rn); }
        }
#pragma unroll
        for (int u = 0; u < 2; ++u) { if (!ok[u]) continue; const int R = R0 + u * NGW;
            if (l > 0) combine_apply(F, y[u], cond[u], l - 1, v[u]);
            float ss = 0.f;
#pragma unroll
            for (int j = 0; j < 4; ++j) { u32x2 xw; xw.x = pk2(v[u][j][0], v[u][j][1]); xw.y = pk2(v[u][j][2], v[u][j][3]); *(u32x2*)(xp[u] + 256 * j + 4 * lane) = xw; ss += (v[u][j][0] * v[u][j][0] + v[u][j][1] * v[u][j][1]) + (v[u][j][2] * v[u][j][2] + v[u][j][3] * v[u][j][3]); }
            const float rstd = 1.f / sqrtf(wave_sum(ss) * (1.f / DM) + EPSN);
            unsigned char* hp8 = F.ws + WS_HA8 + (size_t)R * DM; bf16_t* hp = (bf16_t*)(F.ws + WS_HA) + (size_t)R * DM;
#pragma unroll
            for (int j = 0; j < 4; ++j) { const int c = 256 * j + 4 * lane; const f32x4 g = gnv[j], sh = shv[u][j], sc = scv[u][j];
                f32x4 h = (v[u][j] * rstd) * g; h = h * (sc + 1.f) + sh;
                if (G1_F8_PARTS != 0) *(unsigned*)(hp8 + c) = pk4_fp8(h[0], h[1], h[2], h[3]);
                if (G1_F8_PARTS != 0x7f) { u32x2 w; w.x = pk2(h[0], h[1]); w.y = pk2(h[2], h[3]); *(u32x2*)(hp + c) = w; } }
        }
    }
}
__device__ __forceinline__ void final_phase(const Frame& F, KArgs A) {
    const int gw = F.vcu * NWAVES + F.wave, NGW = F.G * NWAVES, lane = F.lane;
    constexpr int NLAT = NB * SEQ;
    u32x4 tn[2];
#pragma unroll
    for (int u = 0; u < 2; ++u) { const int T = (gw + u * NGW < NLAT) ? gw + u * NGW : gw; const int b = T / SEQ; tn[u] = tokc_load(F, b * PBR + LC + (T - b * SEQ)); }
    for (int T0 = gw; T0 < NLAT; T0 += 2 * NGW) {
        f32x4 v[2][4]; float* xp[2]; int cond[2]; bool ok[2]; YRows y[2]; u32x4 t[2];
#pragma unroll
        for (int u = 0; u < 2; ++u) { const int T = T0 + u * NGW; ok[u] = T < NLAT; const int Tc = ok[u] ? T : T0; const int b = Tc / SEQ; cond[u] = b;
            xp[u] = F.out + (size_t)Tc * DM; const bf16_t* xr = xb_row(F.ws, b * PBR + LC + (Tc - b * SEQ));
#pragma unroll
            for (int j = 0; j < 4; ++j) v[u][j] = bf4(*(const u32x2*)(xr + 256 * j + 4 * lane));
            t[u] = tn[u];
        }
        { const int Tn0 = T0 + 2 * NGW; if (Tn0 < NLAT) {
#pragma unroll
            for (int u = 0; u < 2; ++u) { const int T = (Tn0 + u * NGW < NLAT) ? Tn0 + u * NGW : Tn0; const int b = T / SEQ; tn[u] = tokc_load(F, b * PBR + LC + (T - b * SEQ)); } } }
#pragma unroll
        for (int u = 0; u < 2; ++u) { const int T = ok[u] ? T0 + u * NGW : T0; const int b = T / SEQ; y_load(F, t[u], y[u], b * PBR + LC + (T - b * SEQ)); }
#pragma unroll
        for (int u = 0; u < 2; ++u) { if (!ok[u]) continue;
            if (DBG_STOP_AFTER >= N_PHASES - 2) combine_apply(F, y[u], cond[u], NLAYER - 1, v[u]);
            float ss = 0.f;
#pragma unroll
            for (int j = 0; j < 4; ++j) ss += (v[u][j][0] * v[u][j][0] + v[u][j][1] * v[u][j][1]) + (v[u][j][2] * v[u][j][2] + v[u][j][3] * v[u][j][3]);
            const float rstd = 1.f / sqrtf(wave_sum(ss) * (1.f / DM) + EPSN);
#pragma unroll
            for (int j = 0; j < 4; ++j) { const int c = 256 * j + 4 * lane; const f32x4 g = *(const f32x4*)(A->in[I_GFIN] + c); *(f32x4*)(xp[u] + c) = (v[u][j] * rstd) * g; }
        }
    }
}
__device__ __forceinline__ void r1_phase(const Frame& F, KArgs A, int l, int pv = 0) {
    LAS f32x4* wr4 = (LAS f32x4*)F.lds;
    LAS unsigned* cw = (LAS unsigned*)(F.lds + 65536);
    LAS unsigned* bs = (LAS unsigned*)(F.lds + 65536 + 512);
    LAS unsigned* rec = (LAS unsigned*)(F.lds + 65536 + 1024);
    for (int idx = F.tid; idx < DM * NEXP; idx += NWAVES * 64) { const int k = idx >> 4, e = idx & 15, j = k >> 8, ln = (k & 255) >> 2, i = k & 3, q = e >> 2, t = e & 3;
        ((LAS float*)F.lds)[((((j * 4 + i) * 4 + q) * 64 + ln) << 2) + t] = A->in[I_WROUT][idx]; }
    if (F.tid < 128) cw[F.tid] = 0u;
    __syncthreads();
    const int lane = F.lane, wave = F.wave;
    constexpr int RPW = TR / 256 / NWAVES;
    const bool last = (l == NLAYER - 1);
    u32x2 vn[4];
    { const bf16_t* x0 = xb_row(F.ws, F.vcu * (TR / 256) + wave * RPW);
#pragma unroll
        for (int j = 0; j < 4; ++j) vn[j] = *(const u32x2*)(x0 + 256 * j + 4 * lane); }
    for (int i = 0; i < RPW; ++i) {
        const int R = F.vcu * (TR / 256) + wave * RPW + i;
        const int b = R / PBR, p = R - b * PBR;
        if (last && p < LC) { if (lane == 0) rec[(wave * RPW + i) * 4] = 255u;
            if (i + 1 < RPW) { const bf16_t* xn = xb_row(F.ws, R + 1);
#pragma unroll
                for (int j = 0; j < 4; ++j) vn[j] = *(const u32x2*)(xn + 256 * j + 4 * lane); }
            continue; }
        const int cond = cond_of(R);
        f32x4 v[4]; float ss = 0.f;
#pragma unroll
        for (int j = 0; j < 4; ++j) { v[j] = bf4(vn[j]); ss += (v[j][0] * v[j][0] + v[j][1] * v[j][1]) + (v[j][2] * v[j][2] + v[j][3] * v[j][3]); }
        if (i + 1 < RPW) { const bf16_t* xn = xb_row(F.ws, R + 1);
#pragma unroll
            for (int j = 0; j < 4; ++j) vn[j] = *(const u32x2*)(xn + 256 * j + 4 * lane); }
        const float rstd = 1.f / sqrtf(wave_sum(ss) * (1.f / DM) + EPSN);
        const float* gn = A->in[I_GN2] + l * DM; const float* md = (const float*)(F.ws + WS_MODV) + ((size_t)l * NCOND + cond) * MODW + 3 * DM;
        unsigned char* hp = F.ws + WS_HA + (size_t)R * DM;
        float lg[NEXP];
#pragma unroll
        for (int e = 0; e < NEXP; ++e) lg[e] = 0.f;
        f32x4 gv4[4], shv4[4], scv4[4];
#pragma unroll
        for (int j = 0; j < 4; ++j) { const int c = 256 * j + 4 * lane; gv4[j] = *(const f32x4*)(gn + c); shv4[j] = *(const f32x4*)(md + c); scv4[j] = *(const f32x4*)(md + DM + c); }
#pragma unroll
        for (int j = 0; j < 4; ++j) { const int c = 256 * j + 4 * lane; const f32x4 g = gv4[j], sh = shv4[j], sc = scv4[j];
            f32x4 h = (v[j] * rstd) * g; h = h * (sc + 1.f) + sh;
            *(unsigned*)(hp + c) = pk4_fp8(h[0], h[1], h[2], h[3]);
            if (pv != 1)
#pragma unroll
            for (int ii = 0; ii < 4; ++ii)
#pragma unroll
                for (int q = 0; q < 4; ++q) { const f32x4 w4 = R1_GLOBAL_W ? *(const f32x4*)(A->in[I_WROUT] + (size_t)(c + ii) * NEXP + 4 * q) : wr4[((j * 4 + ii) * 4 + q) * 64 + lane];
                    lg[4 * q + 0] += h[ii] * w4[0]; lg[4 * q + 1] += h[ii] * w4[1]; lg[4 * q + 2] += h[ii] * w4[2]; lg[4 * q + 3] += h[ii] * w4[3]; } }
#pragma unroll
        for (int e = 0; e < NEXP; ++e) lg[e] = (pv == 2 ? lg[e] : wave_sum(lg[e])) + A->in[I_BROUT][e];
        int best = 0; float bv = lg[0];
#pragma unroll
        for (int e = 1; e < NEXP; ++e) if (lg[e] > bv) { bv = lg[e]; best = e; }
        const int grp = best >> 2; int e2 = -1; float v2 = 0.f;
#pragma unroll
        for (int e = 0; e < NEXP; ++e) if ((e >> 2) == grp && e != best && (e2 < 0 || lg[e] > v2)) { v2 = lg[e]; e2 = e; }
        const float g1 = __builtin_amdgcn_rcpf(1.f + __builtin_amdgcn_exp2f(-1.4426950408889634f * fabsf(bv - v2)));
        const unsigned r1 = cw[wave * 16 + best], r2 = cw[wave * 16 + e2];
        LDS_WAIT(); asm volatile("" ::: "memory");
        if (lane == 0) { cw[wave * 16 + best] = r1 + 1u; cw[wave * 16 + e2] = r2 + 1u;
            LAS unsigned* rr = rec + (wave * RPW + i) * 4; rr[0] = (unsigned)best | ((unsigned)e2 << 8); rr[1] = r1; rr[2] = r2; rr[3] = 0u;
            ((float*)(F.ws + WS_TOKGATE))[R] = g1; }
        LDS_WAIT(); asm volatile("" ::: "memory");
    }
    __syncthreads();
    if (F.tid < NEXP) { unsigned run = 0u; for (int w = 0; w < NWAVES; ++w) { bs[w * 16 + F.tid] = run; run += cw[w * 16 + F.tid]; }
        ((unsigned*)(F.ws + WS_CNT))[F.vcu * 16 + F.tid] = run; }
    __syncthreads();
    if (lane < RPW) { const LAS unsigned* rr = rec + (wave * RPW + lane) * 4; const int R = F.vcu * (TR / 256) + wave * RPW + lane;
        u32x4 o; o.x = rr[0];
        if ((o.x & 255u) == 255u) { o.y = 0u; o.z = 0u; o.w = 0u; }
        else { o.y = rr[1] + bs[wave * 16 + (o.x & 255u)]; o.z = rr[2] + bs[wave * 16 + ((o.x >> 8) & 255u)]; o.w = rr[3]; }
        ((u32x4*)(F.ws + WS_TOKINFO))[R] = o; }
    __syncthreads();
}
__device__ __forceinline__ void r2_phase(const Frame& F, KArgs A, int l) {
    LAS unsigned* cn = (LAS unsigned*)F.lds;
    LAS unsigned* pst = (LAS unsigned*)(F.lds + 16384);
    LAS int* tab = (LAS int*)(F.lds + 16384 + 256);
    for (int i = F.tid; i < 256 * 16; i += NWAVES * 64) cn[i] = ((const unsigned*)(F.ws + WS_CNT))[i];
    __syncthreads();
    if (F.tid < NEXP) { unsigned tot = 0u, pre = 0u; for (int w = 0; w < 256; ++w) { const unsigned c = cn[w * 16 + F.tid]; if (w < F.vcu) pre += c; tot += c; }
        pst[32 + F.tid] = tot; pst[16 + F.tid] = pre; }
    __syncthreads();
    if (F.tid == 0) { unsigned run = 0u; for (int e = 0; e < NEXP; ++e) { const unsigned pad = (pst[32 + e] + 255u) & ~255u; pst[e] = run + pst[16 + e];
            for (unsigned bk = run >> 8; bk < ((run + pad) >> 8); ++bk) tab[bk] = e; run += pad; }
        tab[300] = (int)(run >> 8); }
    __syncthreads();
    if (F.vcu == 0) { for (int i = F.tid; i < 320; i += NWAVES * 64) ((int*)(F.ws + WS_BLKTAB))[i] = (i < MAXBLK || i == 300) ? tab[i] : 0; }
    const int lane = F.lane, wave = F.wave;
    constexpr int RPW = TR / 256 / NWAVES;
    const int R0 = F.vcu * (TR / 256) + wave * RPW;
    unsigned s1 = 0u, s2 = 0u, on = 0u;
    if (lane < RPW) { const int R = R0 + lane; const unsigned* ip = (const unsigned*)((const u32x4*)(F.ws + WS_TOKINFO) + R);
        const unsigned ix = ld_dev(ip), iy = ld_dev(ip + 1), iz = ld_dev(ip + 2); const unsigned gt = ld_dev((const float*)(F.ws + WS_TOKGATE) + R);
        on = ((ix & 255u) != 255u) ? 1u : 0u;
        if (on) { s1 = pst[ix & 255u] + iy; s2 = pst[(ix >> 8) & 255u] + iz; }
        u32x4 tc; tc.x = s1; tc.y = s2; tc.z = on ? gt : 0u; tc.w = on; ((u32x4*)(F.ws + WS_TOKC))[R] = tc; }
#pragma unroll
    for (int i0 = 0; i0 < RPW; i0 += 6) {
        u32x4 a[6];
#pragma unroll
        for (int k = 0; k < 6; ++k) if (i0 + k < RPW) a[k] = ((const u32x4*)(F.ws + WS_HA + (size_t)(R0 + i0 + k) * DM))[lane];
#pragma unroll
        for (int k = 0; k < 6; ++k) if (i0 + k < RPW) {
            const unsigned o1 = __builtin_amdgcn_readlane(s1, i0 + k), o2 = __builtin_amdgcn_readlane(s2, i0 + k), v = __builtin_amdgcn_readlane(on, i0 + k);
            if (v) { ((u32x4*)(F.ws + WS_XB + (size_t)o1 * DM))[lane] = a[k]; ((u32x4*)(F.ws + WS_XB + (size_t)o2 * DM))[lane] = a[k]; } }
    }
}
__device__ __forceinline__ void expert_conv_unit(const Frame& F, KArgs A, int l, int cu) {
    LAS float* scr = (LAS float*)(F.lds + F.wave * 8704);
    int ln = F.lane; asm volatile("" : "+v"(ln));
    constexpr int T_M = (DM / 64) * (DM / 32);
#define EC_GEOM(j) const int it = cu * 48 + F.wave * 6 + (j); const int mat = it / T_M, t = it % T_M, e = mat / 3, which = mat % 3, kb = t / 32, nb = t % 32, n0 = 32 * nb; \
        const float* W = A->in[which == 0 ? I_WE1 : (which == 1 ? I_WE3 : I_WE2)] + ((size_t)l * NEXP + e) * DM * DM
    TrRegs tr[2];
    { EC_GEOM(0); tr_load(tr[0], W, DM, 64 * kb, n0, ln); }
#pragma unroll
    for (int j = 0; j < 6; ++j) {
        if (j + 1 < 6) { EC_GEOM(j + 1); tr_load(tr[(j + 1) & 1], W, DM, 64 * kb, n0, ln); }
        EC_GEOM(j);
        unsigned char* dst = which == 2 ? F.ws + WS_W2 + ((size_t)e * DM + n0) * DM
                                        : F.ws + WS_W13 + ((size_t)e * 2048 + (size_t)(n0 >> 7) * 256 + which * 128 + (n0 & 127)) * DM;
        tr_store<true>(tr[j & 1], DM, 64 * kb, dst, scr, ln);
    }
#undef EC_GEOM
    __syncthreads();
}

namespace att {
constexpr float SCALE = 0.125f;
constexpr float TOP = 5.f, SLACK = 3.5f;
constexpr int SHM_V = 64 * 128 * 2, SHM_K = 64 * 128 * 2;
typedef int i32x4 __attribute__((ext_vector_type(4)));
typedef int i32x8 __attribute__((ext_vector_type(8)));
#define KSWZ(row, colB) ((row) * 256 + ((colB) ^ (((row) & 7) << 4)))
__device__ __forceinline__ int crow(int r, int hi) { return (r & 3) + 8 * (r >> 2) + 4 * hi; }
__device__ __forceinline__ void partialSM(f32x16& p0, f32x16& p1, float& m_reg, f32x16& mneg, float& alpha, bool first, int dryv = 0) {
  alpha = 1.f;
  float pmax = p0[0]; if (dryv != 5 && dryv != 9) { for (int r = 1; r < 16; ++r) pmax = fmaxf(pmax, p0[r]); for (int r = 0; r < 16; ++r) pmax = fmaxf(pmax, p1[r]); }
  { auto rr = __builtin_amdgcn_permlane32_swap(__float_as_uint(pmax), __float_as_uint(pmax), false, false);
    pmax = fmaxf(__uint_as_float(rr[0]), __uint_as_float(rr[1])); }
  if (first || !__builtin_expect(__all(pmax <= TOP + SLACK), 1)) { const float d = first ? pmax - TOP : fmaxf(pmax - TOP, 0.f); alpha = __builtin_amdgcn_exp2f(-d); m_reg += d;
    for (int r = 0; r < 16; ++r) p0[r] -= d; for (int r = 0; r < 16; ++r) p1[r] -= d; { const float nm = -m_reg; asm volatile("v_mov_b32 %0, %16\n\tv_mov_b32 %1, %16\n\tv_mov_b32 %2, %16\n\tv_mov_b32 %3, %16\n\tv_mov_b32 %4, %16\n\tv_mov_b32 %5, %16\n\tv_mov_b32 %6, %16\n\tv_mov_b32 %7, %16\n\tv_mov_b32 %8, %16\n\tv_mov_b32 %9, %16\n\tv_mov_b32 %10, %16\n\tv_mov_b32 %11, %16\n\tv_mov_b32 %12, %16\n\tv_mov_b32 %13, %16\n\tv_mov_b32 %14, %16\n\tv_mov_b32 %15, %16"
        : "+v"(mneg[0]), "+v"(mneg[1]), "+v"(mneg[2]), "+v"(mneg[3]), "+v"(mneg[4]), "+v"(mneg[5]), "+v"(mneg[6]), "+v"(mneg[7]), "+v"(mneg[8]), "+v"(mneg[9]), "+v"(mneg[10]), "+v"(mneg[11]), "+v"(mneg[12]), "+v"(mneg[13]), "+v"(mneg[14]), "+v"(mneg[15]) : "v"(nm)); } }
  if (dryv != 2 && dryv != 9) for (int r = 0; r < 16; ++r) p0[r] = __builtin_amdgcn_exp2f(p0[r]);
}
__device__ __forceinline__ void finishSM(f32x16& p0, f32x16& p1, i32x8& pa, int dryv = 0) {
  if (dryv != 2 && dryv != 9) for (int r = 0; r < 16; ++r) p1[r] = __builtin_amdgcn_exp2f(p1[r]);
#pragma unroll
  for (int t = 0; t < 8; ++t) { int w; asm volatile("" : "=v"(w)); w = __builtin_amdgcn_cvt_pk_fp8_f32(p0[t], p0[t + 8], w, false); pa[t] = __builtin_amdgcn_cvt_pk_fp8_f32(p1[t], p1[t + 8], w, true); }
}
#define KSWZ8(row, colB) ((row) * 128 + ((colB) ^ ((((row) >> 1) & 7) << 4)))
__device__ __forceinline__ void qkt(f32x16& p0, f32x16& p1, const char* Ks, const i32x8 qr, int r32, int hi, int csub, const f32x16& mneg) {
  const int cb = csub * 64 + hi * 32;
  const i32x4 a0 = *reinterpret_cast<const i32x4*>(Ks + KSWZ8(r32, cb)), a1 = *reinterpret_cast<const i32x4*>(Ks + KSWZ8(r32, cb + 16));
  const i32x4 b0 = *reinterpret_cast<const i32x4*>(Ks + KSWZ8(32 + r32, cb)), b1 = *reinterpret_cast<const i32x4*>(Ks + KSWZ8(32 + r32, cb + 16));
  p0 = __builtin_amdgcn_mfma_scale_f32_32x32x64_f8f6f4(__builtin_shufflevector(a0, a1, 0, 1, 2, 3, 4, 5, 6, 7), qr, mneg, 0, 0, 0, 0, 0, 0);
  p1 = __builtin_amdgcn_mfma_scale_f32_32x32x64_f8f6f4(__builtin_shufflevector(b0, b1, 0, 1, 2, 3, 4, 5, 6, 7), qr, mneg, 0, 0, 0, 0, 0, 0);
}
struct VRegs { i32x4 lo[4], hh[4]; };
template <int H> __device__ __forceinline__ void pv_load(VRegs& v, const char* Vs, int voff) {
#pragma unroll
  for (int d0 = 2 * H; d0 < 2 * H + 2; ++d0) { v.lo[d0] = *reinterpret_cast<const i32x4*>(Vs + d0 * 2048 + voff); v.hh[d0] = *reinterpret_cast<const i32x4*>(Vs + d0 * 2048 + (voff ^ 16)); }
}
__device__ __forceinline__ void pv_mma(f32x16* o, f32x16& lacc, const i32x8 ones, const VRegs& v, i32x8 pa) {
#pragma unroll
  for (int d0 = 0; d0 < 4; ++d0) { const i32x8 vv = __builtin_shufflevector(v.lo[d0], v.hh[d0], 0, 1, 2, 3, 4, 5, 6, 7);
    o[d0] = __builtin_amdgcn_mfma_scale_f32_32x32x64_f8f6f4(pa, vv, o[d0], 0, 0, 0, 0, 0, 0); }
  lacc = __builtin_amdgcn_mfma_scale_f32_32x32x64_f8f6f4(pa, ones, lacc, 0, 0, 0, 0, 0, 0);
}
__device__ __forceinline__ void attn_unit(const unsigned char* __restrict__ Qb, const unsigned char* __restrict__ Kh, const unsigned char* __restrict__ VTh, unsigned char* Ob,
                                          int seq, float lam, float oscale, const float* __restrict__ gsub, char* lds, LAS unsigned char* ldsl, int tid, bool dry = false) {
  asm volatile("" : "+v"(tid));
  const int wid = __builtin_amdgcn_readfirstlane(tid >> 6), lane = tid & 63, r32 = lane & 31, hi = lane >> 5, csub = wid >> 2, wq = wid & 3;
  constexpr int STG = 16384, VOFF = 8192;
  float* ws = (float*)(lds + 4 * STG) + wid * 64; float* al_l = ws + 32;
  float m_reg = 0.f; f32x16 o[4] = {}, lacc = {}, mneg = {}; i32x8 qr, ones; { int o1 = 0x38383838; asm volatile("" : "+v"(o1)); ones = (i32x8){o1, o1, o1, o1, o1, o1, o1, o1}; }
  { const unsigned char* Qw = Qb + (size_t)(wq * 32 + r32) * DM + csub * 64 + hi * 32;
    const i32x4 q0 = *reinterpret_cast<const i32x4*>(Qw), q1 = *reinterpret_cast<const i32x4*>(Qw + 16); qr = __builtin_shufflevector(q0, q1, 0, 1, 2, 3, 4, 5, 6, 7); }
  const unsigned kofs = (unsigned)((tid >> 3) * DM + (((tid & 7) ^ ((tid >> 4) & 7)) << 4));
  const unsigned vofs = (unsigned)((tid >> 2) * (68 * 64) + (((tid & 3) ^ ((tid >> 4) & 3)) << 4));
  LAS unsigned char* dmaw = ldsl + wid * 1024;
  const int voff = r32 * 64 + (((2 * hi) ^ ((r32 >> 2) & 3)) << 4);
#define DMA(t, S) do { if (!(dry && ATT_VAR == 1)) { LAS unsigned char* d_ = dmaw + (S) * STG; \
    const unsigned ko_ = kofs + (unsigned)(t) * (unsigned)(64 * DM), vo_ = vofs + (unsigned)(t) * 64u;     \
    __builtin_amdgcn_global_load_lds((const unsigned*)(Kh + ko_), (LAS unsigned*)d_, 16, 0, 0); \
    __builtin_amdgcn_global_load_lds((const unsigned*)(VTh + vo_), (LAS unsigned*)(d_ + VOFF), 16, 0, 0); } } while (0)
#define KST(S) (lds + (S) * STG)
#define VST(S) (lds + (S) * STG + VOFF)
#define RESC(a) do { if (__any((a) < 1.f)) { if (hi == 0) al_l[r32] = (a); asm volatile("s_waitcnt lgkmcnt(0)" ::: "memory"); \
    for (int r = 0; r < 16; ++r) { const float a_ = al_l[crow(r, hi)]; lacc[r] *= a_; for (int d = 0; d < 4; ++d) o[d][r] *= a_; } } } while (0)
#define BARRIER() do { if (!(dry && ATT_VAR == 6)) asm volatile("s_barrier" ::: "memory"); } while (0)
  f32x16 pA0, pA1, pB0, pB1; float alA, alB; i32x8 pa; const int NT = seq / 64; VRegs vr;
  DMA(0, 0); DMA(1, 1);
  asm volatile("s_waitcnt vmcnt(2)" ::: "memory"); __syncthreads();
  DMA(2, 2);
  qkt(pA0, pA1, KST(0), qr, r32, hi, csub, mneg); partialSM(pA0, pA1, m_reg, mneg, alA, true);
#define STEP(u, SK, SV, SD, PN0, PN1, ALN, PC0, PC1, VMC, DMACOND) do { \
    asm volatile("s_waitcnt vmcnt(" #VMC ")" ::: "memory"); BARRIER(); if (DMACOND) DMA((u) + 2, SD); \
    SBAR(); pv_load<0>(vr, VST(SV), voff); if (!(dry && (ATT_VAR == 4 || ATT_VAR == 8))) qkt(PN0, PN1, KST(SK), qr, r32, hi, csub, mneg); SBAR(); pv_load<1>(vr, VST(SV), voff); \
    finishSM(PC0, PC1, pa, dry ? ATT_VAR : 0); SBAR(); \
    if (!(dry && (ATT_VAR == 3 || ATT_VAR == 8))) pv_mma(o, lacc, ones, vr, pa); partialSM(PN0, PN1, m_reg, mneg, ALN, false, dry ? ATT_VAR : 0); \
    RESC(ALN); } while (0)
  int u = 1;
  for (; u + 3 < NT; u += 4) {
    STEP(u,     1, 0, 3, pB0, pB1, alB, pA0, pA1, 2, true);
    STEP(u + 1, 2, 1, 0, pA0, pA1, alA, pB0, pB1, 2, true);
    STEP(u + 2, 3, 2, 1, pB0, pB1, alB, pA0, pA1, 2, true);
    STEP(u + 3, 0, 3, 2, pA0, pA1, alA, pB0, pB1, 2, true);
  }
  STEP(u,     1, 0, 3, pB0, pB1, alB, pA0, pA1, 2, true);
  STEP(u + 1, 2, 1, 0, pA0, pA1, alA, pB0, pB1, 2, false);
  STEP(u + 2, 3, 2, 1, pB0, pB1, alB, pA0, pA1, 0, false);
  pv_load<0>(vr, VST(3), voff); pv_load<1>(vr, VST(3), voff); finishSM(pB0, pB1, pa); SBAR();
  pv_mma(o, lacc, ones, vr, pa);
  float rli[16];
#pragma unroll
  for (int r = 0; r < 16; ++r) rli[r] = __builtin_amdgcn_rcpf(lacc[r]);
  __syncthreads();
  float* Cs = (float*)lds;
  if (csub == 1) {
#pragma unroll
    for (int r = 0; r < 16; ++r) { const float f = rli[r] * lam; float* cp = Cs + (wq * 32 + crow(r, hi)) * 128 + r32;
#pragma unroll
      for (int d0 = 0; d0 < 4; ++d0) cp[d0 * 32] = o[d0][r] * f; }
  }
  __syncthreads();
  if (csub == 0) {
    float gs[4];
#pragma unroll
    for (int d0 = 0; d0 < 4; ++d0) gs[d0] = gsub[d0 * 32 + r32] * oscale;
#pragma unroll
    for (int r = 0; r < 16; ++r) { const int row = wq * 32 + crow(r, hi); const float* cp = Cs + row * 128 + r32; float v[4]; float ss = 0.f;
#pragma unroll
      for (int d0 = 0; d0 < 4; ++d0) { v[d0] = o[d0][r] * rli[r] - cp[d0 * 32]; ss += v[d0] * v[d0]; }
      ss = dpp_add<0xB1, 0xF>(ss); ss = dpp_add<0x4E, 0xF>(ss); ss = dpp_add<0x141, 0xF>(ss); ss = dpp_add<0x140, 0xF>(ss);
      { auto rr = __builtin_amdgcn_permlane16_swap(__float_as_uint(ss), __float_as_uint(ss), false, false); ss = __uint_as_float(rr[0]) + __uint_as_float(rr[1]); }
      const float rstd = 1.f / sqrtf(ss * (1.f / 128.f) + EPSN);
      unsigned char* op = Ob + (size_t)row * DM + r32;
#pragma unroll
      for (int d0 = 0; d0 < 4; ++d0) { const float x = v[d0] * rstd * gs[d0]; const unsigned ov = (unsigned)__builtin_amdgcn_cvt_pk_fp8_f32(x, x, 0, false); if (!dry) op[d0 * 32] = (unsigned char)ov; else asm volatile("" :: "v"(ov)); } }
  }
  __syncthreads();
#undef DMA
#undef KST
#undef VST
#undef STEP
#undef BARRIER
#undef RESC
}
}

__device__ __forceinline__ void scan_unit(const Frame& F, KArgs A, int l, int b, int blk, bool dry = false) {
    int tid = F.tid; asm volatile("" : "+v"(tid));
    const int lane = tid & 63, w = F.wave, fr = lane & 15, q4 = lane >> 4, tr = tid >> 4, cg = tid & 15;
    LAS unsigned char* Us = F.lds;
    LAS float* Hs = (LAS float*)(F.lds + 16384);
    const size_t rowb = (size_t)b * PBR;
    const size_t coff = rowb * DM + (size_t)blk * 128 + cg * 8;
    const bf16_t* rxp = (const bf16_t*)(F.ws + WS_PARTS) + coff;
    bf16_t* rgp = (bf16_t*)(F.ws + WS_PARTS) + 4 * PART_ELEMS + coff;
    bf16_t* hfp = (bf16_t*)(F.ws + WS_HA) + coff;
    float zs_ = 0.f; asm volatile("" : "+v"(zs_));
    float cwv[4][8], cbv[8];
#pragma unroll
    for (int i = 0; i < 8; ++i) { cbv[i] = A->in[I_CONVB][l * DM + blk * 128 + cg * 8 + i];
#pragma unroll
        for (int j = 0; j < 4; ++j) cwv[j][i] = A->in[I_CONVW][(l * 4 + j) * DM + blk * 128 + cg * 8 + i]; }
    for (int dir = 0; dir < 2; ++dir) {
        const bf16_t* Wt = (const bf16_t*)(F.ws + WS_WMIX + (size_t)l * WMIX_LAYER + WM_LRU) + (size_t)(dir * 8 + blk) * 256 * 128;
        bf16x8 bfa[4], bfx[4];
#pragma unroll
        for (int kk = 0; kk < 4; ++kk) { bfa[kk] = *(const bf16x8*)(Wt + (size_t)(16 * w + fr) * 128 + kk * 32 + q4 * 8); bfx[kk] = *(const bf16x8*)(Wt + (size_t)(128 + 16 * w + fr) * 128 + kk * 32 + q4 * 8); }
        const int pidx = (l * 2 + dir) * DM + blk * 128 + 16 * w + fr;
        const float ba = A->in[I_LBA][pidx], bx = A->in[I_LBX][pidx], lamv = A->in[I_LLAM][pidx];
        const float cl2 = -8.f * log1pf(expf(-lamv)) * 1.4426950408889634f;
        float h = 0.f;
        u32x4 rxq[2][4], hfq[2], rgq[2];
#define STEP_GEOM(n, T0, LSEG, SEGB) do { const bool sc_ = (n) < 4; const int ci_ = sc_ ? (n) : (n) - 4, nch_ = sc_ ? 4 : 64; T0 = 64 * (dir ? nch_ - 1 - ci_ : ci_); LSEG = sc_ ? LC : SEQ; SEGB = sc_ ? 0 : LC; } while (0)
#define LOAD_RX(n) do { int t0_, ls_, sb_; STEP_GEOM(n, t0_, ls_, sb_); \
        _Pragma("unroll") for (int tk = 0; tk < 2; ++tk) _Pragma("unroll") for (int j = 0; j < 4; ++j) { const int trow = t0_ + tr + 32 * tk + j - 2; \
            const int tc_ = (trow >= 0 && trow < ls_) ? trow : t0_ + tr + 32 * tk;     \
            rxq[tk][j] = *(const u32x4*)(rxp + (size_t)(sb_ + tc_) * DM); } } while (0)
#define LOAD_HG(n) do { int t0_, ls_, sb_; STEP_GEOM(n, t0_, ls_, sb_); \
        _Pragma("unroll") for (int tk = 0; tk < 2; ++tk) { const size_t ro = (size_t)(sb_ + t0_ + tr + 32 * tk) * DM; \
            hfq[tk] = __builtin_nontemporal_load((const u32x4*)(hfp + ro)); rgq[tk] = *(const u32x4*)(rgp + ro); } } while (0)
        LOAD_RX(0); if (dir) LOAD_HG(0);
        for (int n = 0; n < 68; ++n) {
            int t0, lseg, segb; STEP_GEOM(n, t0, lseg, segb);
#pragma unroll
            for (int tk = 0; tk < 2; ++tk) {
                float u[8];
#pragma unroll
                for (int i = 0; i < 8; ++i) u[i] = cbv[i];
#pragma unroll
                for (int j = 0; j < 4; ++j) { u32x4 x = rxq[tk][j];
                    { const int trow = t0 + tr + 32 * tk + j - 2; const unsigned mk = (trow >= 0 && trow < lseg) ? 0xffffffffu : 0u; x.x &= mk; x.y &= mk; x.z &= mk; x.w &= mk; }
                    u[0] += bflo(x.x) * cwv[j][0]; u[1] += bfhi(x.x) * cwv[j][1]; u[2] += bflo(x.y) * cwv[j][2]; u[3] += bfhi(x.y) * cwv[j][3];
                    u[4] += bflo(x.z) * cwv[j][4]; u[5] += bfhi(x.z) * cwv[j][5]; u[6] += bflo(x.w) * cwv[j][6]; u[7] += bfhi(x.w) * cwv[j][7]; }
                const int tl = tr + 32 * tk, tau = dir ? 63 - tl : tl;
                u32x4 wv; wv.x = pk2(u[0], u[1]); wv.y = pk2(u[2], u[3]); wv.z = pk2(u[4], u[5]); wv.w = pk2(u[6], u[7]);
                *(LAS u32x4*)(Us + KSWZ(tau, cg * 16)) = wv;
            }
            if (n + 1 < 68) LOAD_RX(n + 1);
            __syncthreads();
            f32x4 Ga[4], Gx[4];
#pragma unroll
            for (int tt = 0; tt < 4; ++tt) { Ga[tt] = (f32x4){zs_, zs_, zs_, zs_}; Gx[tt] = (f32x4){zs_, zs_, zs_, zs_};
#pragma unroll
                for (int kk = 0; kk < 4; ++kk) { const bf16x8 af = *(const LAS bf16x8*)(Us + KSWZ(16 * tt + fr, 64 * kk + 16 * q4));
                    Ga[tt] = __builtin_amdgcn_mfma_f32_16x16x32_bf16(af, bfa[kk], Ga[tt], 0, 0, 0);
                    Gx[tt] = __builtin_amdgcn_mfma_f32_16x16x32_bf16(af, bfx[kk], Gx[tt], 0, 0, 0); } }
#pragma unroll
            for (int tt = 0; tt < 4; ++tt) {
                float Al[4], Bl[4]; float Ac = 1.f, Bc = 0.f;
#pragma unroll
                for (int rg_ = 0; rg_ < 4; ++rg_) { const int tau = 16 * tt + 4 * q4 + rg_;
                    const float uu = __builtin_bit_cast(float, (unsigned)(*(const LAS unsigned short*)(Us + KSWZ(tau, (16 * w + fr) * 2))) << 16);
                    const float r = fast_sigmoid(Ga[tt][rg_] + ba), av = __builtin_amdgcn_exp2f(cl2 * r), ig = fast_sigmoid(Gx[tt][rg_] + bx);
                    const float bv = __builtin_amdgcn_sqrtf(fmaxf(1.f - av * av, 0.f)) * ig * uu;
                    Bc = av * Bc + bv; Ac = av * Ac; Al[rg_] = Ac; Bl[rg_] = Bc; }
                { const float A1 = __shfl_up(Ac, 16), B1 = __shfl_up(Bc, 16); if (q4 >= 1) { Bc = Ac * B1 + Bc; Ac = Ac * A1; } }
                { const float A2 = __shfl_up(Ac, 32), B2 = __shfl_up(Bc, 32); if (q4 >= 2) { Bc = Ac * B2 + Bc; Ac = Ac * A2; } }
                float Ae = __shfl_up(Ac, 16), Be = __shfl_up(Bc, 16); if (q4 == 0) { Ae = 1.f; Be = 0.f; }
                const float hin = Ae * h + Be;
                const float At = __shfl(Ac, 48 + fr), Bt = __shfl(Bc, 48 + fr);
#pragma unroll
                for (int rg_ = 0; rg_ < 4; ++rg_) Hs[(16 * tt + 4 * q4 + rg_) * 132 + 16 * w + fr] = Al[rg_] * hin + Bl[rg_];
                h = At * h + Bt;
            }
            __syncthreads();
#pragma unroll
            for (int tk = 0; tk < 2; ++tk) { const int tl = tr + 32 * tk, tau = dir ? 63 - tl : tl; const size_t ro = (size_t)(segb + t0 + tl) * DM;
                const f32x4 h0 = *(const LAS f32x4*)(Hs + tau * 132 + cg * 8), h1 = *(const LAS f32x4*)(Hs + tau * 132 + cg * 8 + 4);
                u32x4 o;
                if (dir == 0) { o.x = pk2(h0[0], h0[1]); o.y = pk2(h0[2], h0[3]); o.z = pk2(h1[0], h1[1]); o.w = pk2(h1[2], h1[3]); *(u32x4*)(hfp + ro) = o; }
                else { const u32x4 f = hfq[tk], g = rgq[tk];
                    o.x = pk2((h0[0] + bflo(f.x)) * bflo(g.x), (h0[1] + bfhi(f.x)) * bfhi(g.x)); o.y = pk2((h0[2] + bflo(f.y)) * bflo(g.y), (h0[3] + bfhi(f.y)) * bfhi(g.y));
                    o.z = pk2((h1[0] + bflo(f.z)) * bflo(g.z), (h1[1] + bfhi(f.z)) * bfhi(g.z)); o.w = pk2((h1[2] + bflo(f.w)) * bflo(g.w), (h1[3] + bfhi(f.w)) * bfhi(g.w));
                    if (!dry) *(u32x4*)(rgp + ro) = o; }
            }
            if (dir && n + 1 < 68) LOAD_HG(n + 1);
        }
        VM_WAIT(); __syncthreads();
#undef STEP_GEOM
#undef LOAD_RX
#undef LOAD_HG
    }
}

#ifndef PH_MASK
#define PH_MASK 0xFFF
#endif
#define PH_ON(k) (((PH_MASK) >> (k)) & 1)
#ifndef LAYER_UNROLL
#define LAYER_UNROLL 1
#endif
#ifndef G1_PLAIN_PROBE
#define G1_PLAIN_PROBE 0
#endif
#ifndef R1_VAR
#define R1_VAR 0
#endif
#ifndef A1_DRY
#define A1_DRY 0
#endif
#ifndef P0_SKIP_PROBE
#define P0_SKIP_PROBE 0
#endif
#ifndef E2_NOSTORE_PROBE
#define E2_NOSTORE_PROBE 0
#endif
#ifndef REP_MASK
#define REP_MASK 0
#endif
#define REPS(k) ((((REP_MASK) >> (k)) & 1) ? 2 : 1)
#define REPBAR(k, r) do { if ((r) + 1 < REPS(k)) { KArgs Ab = kargs(); XcdBarrier bar; bar.bar = (unsigned*)(Ab->ws + WS_CTL) + CW_BAR; bar.x = xb_xcc_id(); bar.st = (volatile LAS unsigned*)((LAS unsigned char*)lds + MISC_OFF) + 8; xcd_barrier(bar); } } while (0)
__device__ __forceinline__ Frame make_frame(KArgs A, unsigned char* ldsg, int wave0) {
    Frame F;
    F.lds = (LAS unsigned char*)ldsg; F.ldsg = ldsg;
    F.MISC = (volatile LAS unsigned*)(F.lds + MISC_OFF);
    { unsigned m_ = ~0u; asm volatile("" : "+s"(m_));
      F.tid = wave0 * 64 + (int)__builtin_amdgcn_mbcnt_hi(m_, __builtin_amdgcn_mbcnt_lo(m_, 0u)); asm volatile("" : "+v"(F.tid)); } F.lane = F.tid & 63; F.wave = __builtin_amdgcn_readfirstlane(F.tid >> 6);
    F.G = gridDim.x; { const int bx = blockIdx.x; F.vcu = (F.G % 8 == 0) ? (bx % 8) * (F.G / 8) + bx / 8 : bx; }
    F.ws = A->ws; F.ctl = (unsigned*)(F.ws + WS_CTL); F.out = A->out;
    return F;
}
#ifndef DBG_STOP_AFTER
#define DBG_STOP_AFTER 1000
#endif
#define IN(k) (lo <= (k) && (k) < hi && ((k) <= DBG_STOP_AFTER || (k) == N_PHASES - 1))
#define MKF() asm volatile("; PHASE_MARK" ::: "memory"); KArgs A = kargs(); const Frame F = make_frame(A, lds, wave0)
#define SEAM(k) do { if (IN(k) && IN((k) + 1)) { KArgs Ab = kargs(); XcdBarrier bar; bar.bar = (unsigned*)(Ab->ws + WS_CTL) + CW_BAR; bar.x = xb_xcc_id(); \
        bar.st = (volatile LAS unsigned*)((LAS unsigned char*)lds + MISC_OFF) + 8; xcd_barrier(bar); } } while (0)

template <int l> __device__ __forceinline__ void layer_body(unsigned char* lds, const int lo, const int hi, const int wave0) {
        constexpr int pb = 1 + 9 * l;
        for (int rep_ = 0; rep_ < (l == 0 ? REPS(1) : 1); ++rep_) { if (PH_ON(1) && IN(pb + 0)) { MKF(); n1_phase(F, A, l); } if (l == 0) REPBAR(1, rep_); } SEAM(pb + 0);
        for (int rep_ = 0; rep_ < REPS(2); ++rep_) { if (PH_ON(2) && IN(pb + 1)) { MKF();
            unsigned char* wl = F.ws + WS_WMIX + (size_t)l * WMIX_LAYER;
            constexpr unsigned M8 = G1_F8_PARTS & 0x7f, M16 = ~G1_F8_PARTS & 0x7f; constexpr int NP8 = g1_np(M8), NP16 = g1_np(M16);
            const int plain = (REPS(2) == 2 && rep_ == 0 && G1_PLAIN_PROBE) ? 1 : 0;
            if (NP8) {
                pg8::Gemm g{(const bf16_t*)(F.ws + WS_HA8), (const bf16_t*)(wl + WM_WIN), DM / 2}; OrderG1 S{F.G, (int)blockIdx.x, NP8, g1_plist(M8), true};
                EpiG1 E{(bf16_t*)(F.ws + WS_PARTS), (const float*)(F.ws + WS_COS), (const float*)(F.ws + WS_SIN), F.ws + WS_GATES, plain, 1.f / 32.f};
                pg8::gemm_phase<EpiG1, OrderG1, true, true, true>(F.lds, g, S, E, F.tid);
            }
            if (NP8 && NP16) __syncthreads();
            if (NP16) {
                const int G = F.G, rem8 = (NTILE * 4 * NP8) % G & ~7, c2 = ((int)blockIdx.x - rem8 + G) % G;
                pg8::Gemm g{(const bf16_t*)(F.ws + WS_HA), (const bf16_t*)(wl + WM_WIN), DM}; OrderG1 S{F.G, (F.G % 8 == 0) ? c2 : (int)blockIdx.x, NP16, g1_plist(M16), false};
                EpiG1 E{(bf16_t*)(F.ws + WS_PARTS), (const float*)(F.ws + WS_COS), (const float*)(F.ws + WS_SIN), F.ws + WS_GATES, plain, 1.f};
                pg8::gemm_phase<EpiG1, OrderG1, true, true, false>(F.lds, g, S, E, F.tid);
            }
        } REPBAR(2, rep_); } SEAM(pb + 1);
        if ((PH_ON(3) || PH_ON(4)) && IN(pb + 2)) { MKF();
            bf16_t* const parts = (bf16_t*)(F.ws + WS_PARTS);
            const int total = 64 + 2048 + 512 + (l == 0 ? NB * 8 * 2 : 0);
            const float lam = __builtin_bit_cast(float, __builtin_amdgcn_readfirstlane(ld_dev((const float*)(F.ws + WS_LAM) + l * 2))), oscale = __builtin_bit_cast(float, __builtin_amdgcn_readfirstlane(ld_dev((const float*)(F.ws + WS_LAM) + l * 2 + 1)));
            for (int pass = (A1_DRY ? 0 : 1); pass < 2; ++pass) {
            const bool dry = (pass == 0);
            for (;;) {
                if (F.tid == 0) F.MISC[12] = __hip_atomic_fetch_add(F.ctl + CW_QUEUE + 64 * (l + (dry ? 2 : 0)), 1u, __ATOMIC_RELAXED, __HIP_MEMORY_SCOPE_AGENT);
                __syncthreads();
                const int id = __builtin_amdgcn_readfirstlane((int)F.MISC[12]);
                __syncthreads();
                if (id >= total) break;
                if (id < 64) { if (PH_ON(3) && (!dry || (A1_DRY & 1))) scan_unit(F, A, l, id >> 3, id & 7, dry); continue; }
                if (!PH_ON(4) || (dry && !(A1_DRY & 2))) continue;
                int a = id - 64, b, h, r0, seq;
                if (a < 2048) { const int qb = a & 31; h = (a >> 5) & 7; b = a >> 8; r0 = b * PBR + LC + qb * 128; seq = PBR; }
                else if (a < 2048 + 512) { if (!dry) expert_conv_unit(F, A, l, a - 2048); continue; }
                else { a -= 2048 + 512; const int qb = a & 1; h = (a >> 1) & 7; b = a >> 4; r0 = b * PBR + qb * 128; seq = LC; }
                unsigned char* Ob = (unsigned char*)(parts + 3 * PART_ELEMS) + (size_t)r0 * DM + h * 128;
                const unsigned char* Kh = (const unsigned char*)(parts + 1 * PART_ELEMS) + (size_t)b * PBR * DM + h * 128;
                const unsigned char* Qb = (const unsigned char*)(parts + 1 * PART_ELEMS) + GATE_BYTES + (size_t)r0 * DM + h * 128;
                const unsigned char* Vh = (const unsigned char*)(parts + 2 * PART_ELEMS) + (size_t)(b * DM + h * 128) * (68 * 64);
                att::attn_unit(Qb, Kh, Vh, Ob, seq, lam, oscale, A->in[I_GSUB] + l * 128, (char*)F.ldsg, F.lds, F.tid, dry);
            }
            if (dry) { VM_WAIT(); __syncthreads(); }
            }
        } SEAM(pb + 2);
        for (int rep_ = 0; rep_ < REPS(5); ++rep_) { if (PH_ON(5) && IN(pb + 3)) { MKF();
            unsigned char* wl = F.ws + WS_WMIX + (size_t)l * WMIX_LAYER; bf16_t* const parts = (bf16_t*)(F.ws + WS_PARTS);
            { pg8::Gemm g{parts, (const bf16_t*)(wl + WM_WR), DM}; OrderG2 S{F.G, F.vcu, l == NLAYER - 1, 0, false}; EpiG2 E{parts, F.ws + WS_GATES, 1.f / 255.f, F.ws + WS_HA8};
              pg8::gemm_phase<EpiG2, OrderG2, true, true>(F.lds, g, S, E, F.tid); }
            __syncthreads();
            { pg8::Gemm g{parts, (const bf16_t*)(wl + WM_WR), DM / 2}; OrderG2 S{F.G, F.vcu, l == NLAYER - 1, 1, true}; EpiG2 E{parts, F.ws + WS_GATES, 1.f / (255.f * 32.f), F.ws + WS_HA8};
              pg8::gemm_phase<EpiG2, OrderG2, true, true, true>(F.lds, g, S, E, F.tid); }
        } REPBAR(5, rep_); } SEAM(pb + 3);
        for (int rep_ = 0; rep_ < REPS(6); ++rep_) { if (PH_ON(6) && IN(pb + 4)) { MKF();
            unsigned char* wl = F.ws + WS_WMIX + (size_t)l * WMIX_LAYER; bf16_t* const parts = (bf16_t*)(F.ws + WS_PARTS);
            pg8::Gemm g{G3_F8 ? (const bf16_t*)(F.ws + WS_HA8) : parts, (const bf16_t*)(wl + WM_WO), G3_F8 ? DM / 2 : DM}; OrderG3 S{F.G, F.vcu, l == NLAYER - 1};
            EpiG3 E{F.ws, (const float*)(F.ws + WS_MODV) + (size_t)l * NCOND * MODW, (G3_F8 ? 1.f / 32.f : 1.f) / (float)REPS(6)};
            pg8::gemm_phase<EpiG3, OrderG3, true, true, G3_F8 != 0>(F.lds, g, S, E, F.tid);
        } REPBAR(6, rep_); } SEAM(pb + 4);
        for (int rep_ = 0; rep_ < REPS(7); ++rep_) { if (PH_ON(7) && IN(pb + 5)) { MKF(); r1_phase(F, A, l, (REPS(7) == 2 && rep_ == 0) ? R1_VAR : 0); } REPBAR(7, rep_); } SEAM(pb + 5);
        for (int rep_ = 0; rep_ < REPS(8); ++rep_) { if (PH_ON(8) && IN(pb + 6)) { MKF(); r2_phase(F, A, l); } REPBAR(8, rep_); } SEAM(pb + 6);
        for (int rep_ = 0; rep_ < REPS(9); ++rep_) { if (PH_ON(9) && IN(pb + 7)) { MKF();
            LAS int* tabL = (LAS int*)(F.lds + TAB_OFF);
            for (int i = F.tid; i < 320; i += NWAVES * 64) tabL[i] = ((const int*)(F.ws + WS_BLKTAB))[i];
            __syncthreads();
            const int nblk = __builtin_amdgcn_readfirstlane(tabL[300]);
            pg8::Gemm g{(const bf16_t*)F.ws, (const bf16_t*)F.ws, DM / 2};
            OrderE S{F.G, F.vcu, nblk, 8, tabL, (int)(WS_XB / F8_TILE), (int)(WS_W13 / F8_TILE)}; EpiE1 E{F.ws + WS_ACT};
            pg8::gemm_phase<EpiE1, OrderE, true, true, true>(F.lds, g, S, E, F.tid);
        } REPBAR(9, rep_); } SEAM(pb + 7);
        for (int rep_ = 0; rep_ < REPS(10); ++rep_) { if (PH_ON(10) && IN(pb + 8)) { MKF();
            LAS int* tabL = (LAS int*)(F.lds + TAB_OFF);
            for (int i = F.tid; i < 320; i += NWAVES * 64) tabL[i] = ((const int*)(F.ws + WS_BLKTAB))[i];
            __syncthreads();
            const int nblk = __builtin_amdgcn_readfirstlane(tabL[300]);
            pg8::Gemm g{(const bf16_t*)F.ws, (const bf16_t*)F.ws, DM / 2};
            OrderE S{F.G, F.vcu, nblk, 4, tabL, (int)(WS_ACT / F8_TILE), (int)(WS_W2 / F8_TILE)}; EpiE2 E{F.ws + WS_XB, (REPS(10) == 2 && rep_ == 0 && E2_NOSTORE_PROBE) ? 1 : 0};
            pg8::gemm_phase<EpiE2, OrderE, true, true, true>(F.lds, g, S, E, F.tid);
        } REPBAR(10, rep_); } SEAM(pb + 8);
    }
__global__ void __launch_bounds__(NWAVES * 64, 2) fwd_kernel(Args args_in_kernarg_segment) {
    extern __shared__ __attribute__((aligned(16))) unsigned char lds[];
    for (int u = threadIdx.x; u < (LDS_BYTES - LDSCTL_OFF) / 4; u += NWAVES * 64) ((LAS unsigned*)((LAS unsigned char*)lds + LDSCTL_OFF))[u] = 0u;
    __syncthreads();
    int lo, hi; const int wave0 = __builtin_amdgcn_readfirstlane((int)threadIdx.x >> 6);
    { KArgs A = kargs(); lo = A->ph_lo; hi = A->ph_hi; (void)xcd_barrier_post((unsigned*)(A->ws + WS_CTL) + CW_BAR, (volatile LAS unsigned*)((LAS unsigned char*)lds + MISC_OFF) + 8); }
    for (int rep_ = 0; rep_ < REPS(0); ++rep_) { if (PH_ON(0) && IN(0)) { MKF(); p0_phase(F, A, (REPS(0) == 2 && rep_ == 0) ? P0_SKIP_PROBE : 0); } REPBAR(0, rep_); } SEAM(0);
    layer_body<0>(lds, lo, hi, wave0);
    layer_body<1>(lds, lo, hi, wave0);
    if (PH_ON(11) && IN(N_PHASES - 1)) { MKF(); final_phase(F, A); }
#undef IN
#undef SEAM
#undef MKF
}


#if MK_VERIFY
constexpr int CW_VFLAG = 12000;
__device__ __forceinline__ float vbf(float x) { return __builtin_bit_cast(float, f2bf(x) << 16); }
__global__ void verify_r1(Args a, int l) {
    const int lane = threadIdx.x & 63, gw = (blockIdx.x * blockDim.x + threadIdx.x) >> 6;
    const int R = (gw * 131 + 7) % TR; const int b = R / PBR, p = R - b * PBR; const int cond = p < LC ? 8 : b;
    const float* xp = p < LC ? (const float*)(a.ws + WS_XC) + ((size_t)b * LC + p) * DM : a.out + ((size_t)b * SEQ + (p - LC)) * DM;
    float ss = 0.f; for (int k = lane; k < DM; k += 64) ss += xp[k] * xp[k];
    ss = wave_sum(ss); const float rstd = 1.f / sqrtf(ss / DM + EPSN);
    const float* md = (const float*)(a.ws + WS_MODV) + ((size_t)l * NCOND + cond) * MODW;
    float lg[16]; for (int e = 0; e < 16; ++e) lg[e] = 0.f;
    for (int k = lane; k < DM; k += 64) { const float h = xp[k] * rstd * a.in[I_GN2][l * DM + k] * (1.f + md[4 * DM + k]) + md[3 * DM + k];
        for (int e = 0; e < 16; ++e) lg[e] += h * a.in[I_WROUT][k * 16 + e]; }
    for (int e = 0; e < 16; ++e) lg[e] = wave_sum(lg[e]) + a.in[I_BROUT][e];
    int best = 0; for (int e = 1; e < 16; ++e) if (lg[e] > lg[best]) best = e;
    int e2 = -1; for (int e = 0; e < 16; ++e) if ((e >> 2) == (best >> 2) && e != best && (e2 < 0 || lg[e] > lg[e2])) e2 = e;
    float m1 = 1e30f; for (int e = 0; e < 16; ++e) if (e != best) m1 = fminf(m1, lg[best] - lg[e]);
    float m2 = 1e30f; for (int e = 0; e < 16; ++e) if ((e >> 2) == (best >> 2) && e != best && e != e2) m2 = fminf(m2, lg[e2] - lg[e]);
    const u32x4 info = ((const u32x4*)(a.ws + WS_TOKINFO))[R];
    const float g1 = 1.f / (1.f + expf(lg[e2] - lg[best]));
    unsigned* fl = (unsigned*)(a.ws + WS_CTL) + CW_VFLAG;
    if (lane == 0 && m1 > 1e-3f && m2 > 1e-3f) {
        if ((int)(info.x & 255u) != best) atomicAdd(fl + 8, 1u);
        if ((int)((info.x >> 8) & 255u) != e2) atomicAdd(fl + 9, 1u);
        if (fabsf(((const float*)(a.ws + WS_TOKGATE))[R] - g1) > 1e-3f) atomicAdd(fl + 10, 1u);
        if ((info.x & 255u) == 255u) atomicAdd(fl + 11, 1u);
        if (info.w == 0u) atomicAdd(fl + 15, 1u); if (info.w != 0u && info.w < 65536u) atomicAdd(fl + 16, 1u); if (info.w == info.z) atomicAdd(fl + 17, 1u); if (info.w == info.y) atomicAdd(fl + 18, 1u);
        { const float gw_ = __builtin_bit_cast(float, info.w); if (fabsf(gw_) < 1e-6f) atomicAdd(fl + 12, 1u); if (!(gw_ >= 0.5f && gw_ <= 1.f)) atomicAdd(fl + 13, 1u); if (fabsf(gw_ - (1.f - g1)) < 1e-3f) atomicAdd(fl + 14, 1u); }
        if ((int)(info.x & 255u) != best || (int)((info.x >> 8) & 255u) != e2 || fabsf(__builtin_bit_cast(float, info.w) - g1) > 1e-3f) atomicAdd(fl + 0, 1u);
    }
}
__global__ void verify_r2(Args a) {
    const int lane = threadIdx.x & 63, gw = (blockIdx.x * blockDim.x + threadIdx.x) >> 6;
    const int R = (gw * 131 + 7) % TR;
    const u32x4 info = ((const u32x4*)(a.ws + WS_TOKINFO))[R]; if ((info.x & 255u) == 255u) return;
    const u32x4 sl = ((const u32x4*)(a.ws + WS_TOKC))[R]; const int* tab = (const int*)(a.ws + WS_BLKTAB);
    bool bad = false; const int nblk = tab[300];
    if ((int)(sl.x >> 8) >= nblk || (int)(sl.y >> 8) >= nblk || nblk > MAXBLK) bad = true;
    else { if (tab[sl.x >> 8] != (int)(info.x & 255u) || tab[sl.y >> 8] != (int)((info.x >> 8) & 255u)) bad = true;
        const unsigned* h = (const unsigned*)((const bf16_t*)(a.ws + WS_HA) + (size_t)R * DM); const unsigned* x1 = (const unsigned*)((const bf16_t*)(a.ws + WS_XB) + (size_t)sl.x * DM); const unsigned* x2 = (const unsigned*)((const bf16_t*)(a.ws + WS_XB) + (size_t)sl.y * DM);
        for (int k = lane; k < DM / 2; k += 64) if (h[k] != x1[k] || h[k] != x2[k]) bad = true; }
    if (__any(bad) && lane == 0) atomicAdd((unsigned*)(a.ws + WS_CTL) + CW_VFLAG + 1, 1u);
}
__global__ void verify_e1(Args a, int l) {
    const int lane = threadIdx.x & 63, gw = (blockIdx.x * blockDim.x + threadIdx.x) >> 6;
    const int R = (gw * 131 + 7) % TR;
    const u32x4 info = ((const u32x4*)(a.ws + WS_TOKINFO))[R]; if ((info.x & 255u) == 255u) return;
    const u32x4 sl = ((const u32x4*)(a.ws + WS_TOKC))[R];
    const unsigned slot = (gw & 1) ? sl.y : sl.x; const int e = (gw & 1) ? (int)((info.x >> 8) & 255u) : (int)(info.x & 255u);
    const int n = ((gw * 37) % 16) * 64 + lane;
    const bf16_t* xb = (const bf16_t*)(a.ws + WS_XB) + (size_t)slot * DM;
    const float* w1 = a.in[I_WE1] + ((size_t)l * NEXP + e) * DM * DM, *w3 = a.in[I_WE3] + ((size_t)l * NEXP + e) * DM * DM;
    float s1 = 0.f, s3 = 0.f;
    for (int k = 0; k < DM; ++k) { const float x = __builtin_bit_cast(float, (unsigned)xb[k] << 16); s1 += x * vbf(w1[(size_t)k * DM + n]); s3 += x * vbf(w3[(size_t)k * DM + n]); }
    const float ref = s1 / (1.f + expf(-s1)) * s3;
    const float got = __builtin_bit_cast(float, (unsigned)((const bf16_t*)(a.ws + WS_ACT))[(size_t)slot * DM + n] << 16);
    const bool bad = !(fabsf(got - ref) <= 0.03f * fabsf(ref) + 0.03f);
    if (__any(bad) && lane == 0) atomicAdd((unsigned*)(a.ws + WS_CTL) + CW_VFLAG + 2, 1u);
}
__global__ void verify_e2(Args a, int l) {
    const int lane = threadIdx.x & 63, gw = (blockIdx.x * blockDim.x + threadIdx.x) >> 6;
    const int R = (gw * 131 + 7) % TR;
    const u32x4 info = ((const u32x4*)(a.ws + WS_TOKINFO))[R]; if ((info.x & 255u) == 255u) return;
    const u32x4 sl = ((const u32x4*)(a.ws + WS_TOKC))[R];
    const unsigned slot = (gw & 1) ? sl.y : sl.x; const int e = (gw & 1) ? (int)((info.x >> 8) & 255u) : (int)(info.x & 255u);
    const int n = ((gw * 37) % 16) * 64 + lane;
    const bf16_t* ac = (const bf16_t*)(a.ws + WS_ACT) + (size_t)slot * DM;
    const float* w2 = a.in[I_WE2] + ((size_t)l * NEXP + e) * DM * DM;
    float s = 0.f;
    for (int k = 0; k < DM; ++k) s += __builtin_bit_cast(float, (unsigned)ac[k] << 16) * vbf(w2[(size_t)k * DM + n]);
    const float got = __builtin_bit_cast(float, (unsigned)((const bf16_t*)(a.ws + WS_XB))[(size_t)slot * DM + n] << 16);
    const bool bad = !(fabsf(got - s) <= 0.03f * fabsf(s) + 0.03f);
    if (__any(bad) && lane == 0) atomicAdd((unsigned*)(a.ws + WS_CTL) + CW_VFLAG + 3, 1u);
}
__global__ void verify_encode(Args a) {
    const unsigned* f = (const unsigned*)(a.ws + WS_CTL) + CW_VFLAG;
    const unsigned cnt = f[MK_VCHECK];
    if (cnt == 0u) return;
    const float s = 0.7f - 0.7f * fminf((float)cnt / 512.f, 1.f);
    for (size_t i = (size_t)blockIdx.x * blockDim.x + threadIdx.x; i < (size_t)NB * SEQ * DM; i += (size_t)gridDim.x * blockDim.x) a.out[i] *= s;
}
#endif
extern "C" void kernel_launch(void* const* d_in, const int* in_sizes, int n_in, void* d_out, int out_size, void* d_ws, size_t ws_size, hipStream_t stream) {
    static int grid = 0;
    if (grid == 0) {
        if (n_in != 27 || out_size != NB * SEQ * DM || ws_size < WS_END) { fprintf(stderr, "kernel_launch: shape mismatch (n_in %d out %d ws %zu, need ws >= %zu)\n", n_in, out_size, ws_size, (size_t)WS_END); grid = -1; return; }
        int dev = 0, cus = 0, per_cu = 0;
        if (hipGetDevice(&dev) != hipSuccess || hipDeviceGetAttribute(&cus, hipDeviceAttributeMultiprocessorCount, dev) != hipSuccess) { grid = -1; return; }
        if (hipFuncSetAttribute((const void*)fwd_kernel, hipFuncAttributeMaxDynamicSharedMemorySize, LDS_BYTES) != hipSuccess) { fprintf(stderr, "kernel_launch: hipFuncSetAttribute failed\n"); grid = -1; return; }
        if (hipOccupancyMaxActiveBlocksPerMultiprocessor(&per_cu, (const void*)fwd_kernel, NWAVES * 64, LDS_BYTES) != hipSuccess || per_cu < 1) { fprintf(stderr, "kernel_launch: occupancy query says %d\n", per_cu); }
        (void)hipGetLastError();
        grid = cus;
    }
    if (grid < 0) return;
    if (hipMemsetAsync((char*)d_ws + WS_CTL, 0, CTL_ZERO_BYTES, stream) != hipSuccess) return;
    Args a{};
    for (int i = 0; i < 27; ++i) a.in[i] = (const float*)d_in[i];
    a.out = (float*)d_out; a.ws = (unsigned char*)d_ws;
#if MK_PER_PHASE
    for (int k = 0; k < N_PHASES; ++k) { a.ph_lo = k; a.ph_hi = k + 1; hipLaunchKernelGGL(fwd_kernel, dim3(grid), dim3(NWAVES * 64), LDS_BYTES, stream, a);
#if MK_VERIFY
        const int vl = MK_VERIFY - 1, pb = 1 + 9 * vl;
        if (k == pb + 5) hipLaunchKernelGGL(verify_r1, dim3(128), dim3(256), 0, stream, a, vl);
        if (k == pb + 6) hipLaunchKernelGGL(verify_r2, dim3(128), dim3(256), 0, stream, a);
        if (k == pb + 7) hipLaunchKernelGGL(verify_e1, dim3(128), dim3(256), 0, stream, a, vl);
        if (k == pb + 8) hipLaunchKernelGGL(verify_e2, dim3(128), dim3(256), 0, stream, a, vl);
        if (k == N_PHASES - 1) hipLaunchKernelGGL(verify_encode, dim3(1024), dim3(256), 0, stream, a);
#endif
    }
#else
    a.ph_lo = 0; a.ph_hi = N_PHASES;
    hipLaunchKernelGGL(fwd_kernel, dim3(grid), dim3(NWAVES * 64), LDS_BYTES, stream, a);
#endif
    const hipError_t le = hipPeekAtLastError();
    if (le != hipSuccess) fprintf(stderr, "kernel_launch: launch failed: %s\n", hipGetErrorName(le));
}
```

```cpp
#include <hip/hip_runtime.h>
#include <cstdio>
#include <cstdint>

#ifndef MK_PER_PHASE
#define MK_PER_PHASE 0
#endif

#ifndef MK_VERIFY
#define MK_VERIFY 0
#endif
#ifndef MK_VCHECK
#define MK_VCHECK 0
#endif
#ifndef ATT_PRIO
#define ATT_PRIO 0
#endif
#ifndef ATT_VAR
#define ATT_VAR 0
#endif
#define GAS __attribute__((address_space(1)))
#define LAS __attribute__((address_space(3)))
typedef short s16x4 __attribute__((ext_vector_type(4)));
typedef float f32x16 __attribute__((ext_vector_type(16)));
typedef unsigned u32x2 __attribute__((ext_vector_type(2)));

namespace pg8 {
#define PG8_LAS __attribute__((address_space(3)))
typedef unsigned short bf16_t;
typedef short bf16x8 __attribute__((ext_vector_type(8)));
typedef float f32x4 __attribute__((ext_vector_type(4)));
typedef unsigned u32x4 __attribute__((ext_vector_type(4)));
typedef float f32x2 __attribute__((ext_vector_type(2)));
constexpr int BM = 256, BK = 64, HALF = 128, HTB = HALF * BK * 2  , STAGE_BYTES = 8 * HTB, NXCD = 8, WGM = 8;

__host__ __device__ __forceinline__ int lds_byte(int r, int c) { const int st = (r >> 4) * 2 + (c >> 5), rr = r & 15, cc = c & 31, ob = rr * 64 + cc * 2; return st * 1024 + (ob ^ (((ob >> 9) & 1) << 5)); }
__host__ __device__ __forceinline__ void stage_rc(int b, int& R, int& C) { const int st = b / 1024, sb = b % 1024, swz = sb ^ (((sb >> 9) & 1) << 5); R = (st >> 1) * 16 + swz / 64; C = (st & 1) * 32 + (swz % 64) / 2; }
__host__ __device__ __forceinline__ int perm32(int rho) { const int n = rho >> 4, i = rho & 15; return 8 * (i >> 2) + 4 * n + (i & 3); }

struct Unit { int pm, pn, pa, pb, sub; };
struct Gemm { const bf16_t* A; const bf16_t* Bt; int K; };

struct StaticOrder {
    int nM, nN, nwg, G, c;
    __host__ __device__ void init(int M, int N, int G_, int c_) { nM = M / BM; nN = N / BM; nwg = nM * nN; G = G_; c = c_; }
    __host__ __device__ bool next(int i, Unit& u) const {
        const long L = (long)i * G + c; if (L >= nwg) return false;
        int wgid = (int)L; { const int q = nwg / NXCD, r = nwg % NXCD, xcd = wgid % NXCD, off = wgid / NXCD; wgid = (xcd < r ? xcd * (q + 1) : r * (q + 1) + (xcd - r) * q) + off; }
        const int nig = WGM * nN, gid = wgid / nig, fm = gid * WGM, gsz = (nM - fm) < WGM ? (nM - fm) : WGM;
        u.pm = fm + ((wgid % nig) % gsz); u.pn = (wgid % nig) / gsz; u.pa = u.pm; u.pb = u.pn; u.sub = 0; return true;
    }
    __device__ __forceinline__ void a_ready(const Unit&) const {}
    __device__ __forceinline__ void done(const Unit&) const {}
};

__device__ __forceinline__ unsigned cvt_pk_bf16(float lo, float hi) { unsigned r; asm volatile("v_cvt_pk_bf16_f32 %0, %1, %2" : "=v"(r) : "v"(lo), "v"(hi)); return r; }

template <class Epi, class Sched, bool ALIGN_EPI = false, bool SP2 = false, bool F8 = false>
__device__ __forceinline__ void gemm_phase(PG8_LAS unsigned char* lds, const Gemm g, const Sched& S, const Epi& E, const int tid  ) {
    const int wid = __builtin_amdgcn_readfirstlane(tid >> 6), lane = tid & 63, wr = wid >> 2, wc = wid & 3, fr = lane & 15, fq = lane >> 4;
    const int K = g.K, nt = K / BK;
    unsigned voffA[2], voffB[2];
#pragma unroll
    for (int i = 0; i < 2; ++i) { int R, C; stage_rc(tid * 16 + i * 8192, R, C); const int Rb = Epi::PERM ? ((R & ~31) + perm32(R & 31)) : R;
        voffA[i] = (unsigned)(R * K + C) * 2u; voffB[i] = (unsigned)(Rb * K + C) * 2u; }
    const size_t kstep = (size_t)(BK * 2);
    const size_t hstep = (size_t)HALF * K * 2;
    const size_t tstep = 2 * hstep;
    const unsigned ldsw = (unsigned)wid * 1024u;
    const int aoff = lds_byte(wr * 64 + fr, fq * 8), boff = lds_byte(wc * 32 + fr, fq * 8);
#define PG8_SA(b, h) (((b) * 2 + (h)) * HTB)
#define PG8_SB(b, h) ((4 + (b) * 2 + (h)) * HTB)
#define PG8_STAGE(bufoff, gbase, voff) do { _Pragma("unroll") for (int _i = 0; _i < 2; ++_i) \
        __builtin_amdgcn_global_load_lds((const unsigned*)((const char*)(gbase) + (voff)[_i]), (PG8_LAS unsigned*)(lds + (bufoff) + ldsw + _i * 8192), 16, 0, 0); } while (0)
#define PG8_LD8(addr) __builtin_shufflevector(*(const PG8_LAS i32x4_*)(addr), *(const PG8_LAS i32x4_*)((addr) + 1024), 0, 1, 2, 3, 4, 5, 6, 7)
#define PG8_LDA(dst, b, h) do { if constexpr (F8) { _Pragma("unroll") for (int m = 0; m < 4; ++m) dst##8[m] = PG8_LD8(lds + PG8_SA(b, h) + aoff + m * 2048); } \
        else { _Pragma("unroll") for (int m = 0; m < 4; ++m) _Pragma("unroll") for (int k = 0; k < 2; ++k) dst[m][k] = *(const PG8_LAS bf16x8*)(lds + PG8_SA(b, h) + aoff + m * 2048 + k * 1024); } } while (0)
#define PG8_LDB(dst, b, h) do { if constexpr (F8) { _Pragma("unroll") for (int n = 0; n < 2; ++n) dst##8[n] = PG8_LD8(lds + PG8_SB(b, h) + boff + n * 2048); } \
        else { _Pragma("unroll") for (int n = 0; n < 2; ++n) _Pragma("unroll") for (int k = 0; k < 2; ++k) dst[n][k] = *(const PG8_LAS bf16x8*)(lds + PG8_SB(b, h) + boff + n * 2048 + k * 1024); } } while (0)
#define PG8_MMA(ai, bj, At, Bt) do { __builtin_amdgcn_s_setprio(1); _Pragma("unroll") for (int m = 0; m < 4; ++m) _Pragma("unroll") for (int n = 0; n < 2; ++n) { \
        if constexpr (F8) asm volatile("v_mfma_f32_16x16x128_f8f6f4 %0, %1, %2, %0" : "+v"(acc[ai][bj][m][n]) : "v"(Bt##8[n]), "v"(At##8[m]));     \
        else { _Pragma("unroll") for (int k = 0; k < 2; ++k) acc[ai][bj][m][n] = __builtin_amdgcn_mfma_f32_16x16x32_bf16(Bt[n][k], At[m][k], acc[ai][bj][m][n], 0, 0, 0); } } \
        __builtin_amdgcn_s_setprio(0); } while (0)
#define PG8_WAIT_V(n) asm volatile("s_waitcnt vmcnt(" #n ")" ::: "memory")
#define PG8_WAIT_L(n) asm volatile("s_waitcnt lgkmcnt(" #n ")" ::: "memory")
#define PG8_BAR __builtin_amdgcn_s_barrier()
#define PG8_SCHED __builtin_amdgcn_sched_barrier(0)
    Unit cur, nxt; int ui = 0;
    if (!S.next(0, cur)) return;
    float zf_ = 0.f; asm volatile("" : "+v"(zf_));
    f32x4 acc[2][2][4][2];
#pragma unroll
    for (int a = 0; a < 2; ++a)
#pragma unroll
        for (int b = 0; b < 2; ++b)
#pragma unroll
            for (int m = 0; m < 4; ++m)
#pragma unroll
                for (int n = 0; n < 2; ++n) acc[a][b][m][n] = (f32x4){zf_, zf_, zf_, zf_};
    typedef int i32x4_ __attribute__((ext_vector_type(4))); typedef int i32x8_ __attribute__((ext_vector_type(8)));
    bf16x8 At[4][2], B0[2][2], B1[2][2];
    i32x8_ At8[4], B08[2], B18[2];
    const char* cA = (const char*)g.A + (size_t)cur.pa * tstep; const char* cB = (const char*)g.Bt + (size_t)cur.pb * tstep;
    S.a_ready(cur);
    if constexpr (SP2) {
        PG8_STAGE(PG8_SB(0, 0), cB, voffB); PG8_STAGE(PG8_SB(0, 1), cB + hstep, voffB); PG8_STAGE(PG8_SA(0, 0), cA, voffA); PG8_STAGE(PG8_SA(0, 1), cA + hstep, voffA);
        if (wr == 1) PG8_BAR;
        PG8_WAIT_V(2); PG8_BAR;
        PG8_STAGE(PG8_SB(1, 0), cB + kstep, voffB); PG8_STAGE(PG8_SA(1, 0), cA + kstep, voffA); PG8_STAGE(PG8_SB(1, 1), cB + hstep + kstep, voffB);
        PG8_WAIT_V(6); PG8_BAR;
    } else {
        PG8_STAGE(PG8_SB(0, 0), cB, voffB); PG8_STAGE(PG8_SA(0, 0), cA, voffA); PG8_STAGE(PG8_SB(0, 1), cB + hstep, voffB); PG8_STAGE(PG8_SA(0, 1), cA + hstep, voffA);
        if (wr == 1) PG8_BAR;
        PG8_WAIT_V(4); PG8_BAR;
        PG8_STAGE(PG8_SB(1, 0), cB + kstep, voffB); PG8_STAGE(PG8_SA(1, 0), cA + kstep, voffA); PG8_STAGE(PG8_SB(1, 1), cB + hstep + kstep, voffB);
        PG8_WAIT_V(6); PG8_BAR;
    }
    for (;;) {
        const bool has_next = S.next(ui + 1, nxt);
        const char* nA = has_next ? (const char*)g.A + (size_t)nxt.pa * tstep : cA; const char* nB = has_next ? (const char*)g.Bt + (size_t)nxt.pb * tstep : cB;
#pragma nounroll
        for (int t = 0; t < nt; t += 2) {
            const bool last = (t == nt - 2);
            const char* a1 = cA + (size_t)(t + 1) * kstep;
            const char* a2 = last ? nA : cA + (size_t)(t + 2) * kstep; const char* b2 = last ? nB : cB + (size_t)(t + 2) * kstep;
            const char* a3 = a2 + kstep; const char* b3 = b2 + kstep;
            if (last && has_next) S.a_ready(nxt);
            if constexpr (SP2) {
            PG8_LDB(B0, 0, 0); PG8_LDB(B1, 0, 1); PG8_SCHED; PG8_LDA(At, 0, 0); PG8_STAGE(PG8_SA(1, 1), a1 + hstep, voffA);
            PG8_WAIT_V(8); PG8_WAIT_L(0); PG8_BAR; PG8_MMA(0, 0, At, B0); PG8_MMA(0, 1, At, B1); PG8_BAR; PG8_SCHED;
            PG8_LDA(At, 0, 1); PG8_STAGE(PG8_SB(0, 0), b2, voffB); PG8_STAGE(PG8_SB(0, 1), b2 + hstep, voffB); PG8_STAGE(PG8_SA(0, 0), a2, voffA);
            PG8_WAIT_V(8); PG8_WAIT_L(0); PG8_BAR; PG8_MMA(1, 0, At, B0); PG8_MMA(1, 1, At, B1); PG8_BAR; PG8_SCHED;
            PG8_LDB(B0, 1, 0); PG8_LDB(B1, 1, 1); PG8_SCHED; PG8_LDA(At, 1, 0); PG8_STAGE(PG8_SA(0, 1), a2 + hstep, voffA);
            PG8_WAIT_V(8); PG8_WAIT_L(0); PG8_BAR; PG8_MMA(0, 0, At, B0); PG8_MMA(0, 1, At, B1); PG8_BAR; PG8_SCHED;
            PG8_LDA(At, 1, 1); PG8_STAGE(PG8_SB(1, 0), b3, voffB); PG8_STAGE(PG8_SB(1, 1), b3 + hstep, voffB); PG8_STAGE(PG8_SA(1, 0), a3, voffA);
            PG8_WAIT_V(8); PG8_WAIT_L(0); PG8_BAR; PG8_MMA(1, 0, At, B0); PG8_MMA(1, 1, At, B1); PG8_BAR; PG8_SCHED;
            } else {
            PG8_LDB(B0, 0, 0); PG8_SCHED; PG8_LDA(At, 0, 0); PG8_STAGE(PG8_SA(1, 1), a1 + hstep, voffA);
            PG8_WAIT_L(8); PG8_BAR; PG8_WAIT_L(0); PG8_MMA(0, 0, At, B0); PG8_BAR; PG8_SCHED;
            PG8_LDB(B1, 0, 1); PG8_STAGE(PG8_SB(0, 0), b2, voffB);
            PG8_BAR; PG8_WAIT_L(0); PG8_MMA(0, 1, At, B1); PG8_BAR;
            PG8_LDA(At, 0, 1); PG8_STAGE(PG8_SA(0, 0), a2, voffA);
            PG8_BAR; PG8_WAIT_L(0); PG8_MMA(1, 0, At, B0); PG8_BAR; PG8_SCHED;
            PG8_STAGE(PG8_SB(0, 1), b2 + hstep, voffB);
            PG8_WAIT_V(6); PG8_BAR; PG8_MMA(1, 1, At, B1); PG8_BAR;
            PG8_LDB(B0, 1, 0); PG8_SCHED; PG8_LDA(At, 1, 0); PG8_STAGE(PG8_SA(0, 1), a2 + hstep, voffA);
            PG8_WAIT_L(8); PG8_BAR; PG8_WAIT_L(0); PG8_MMA(0, 0, At, B0); PG8_BAR; PG8_SCHED;
            PG8_LDB(B1, 1, 1); PG8_STAGE(PG8_SB(1, 0), b3, voffB);
            PG8_BAR; PG8_WAIT_L(0); PG8_MMA(0, 1, At, B1); PG8_BAR;
            PG8_LDA(At, 1, 1); PG8_STAGE(PG8_SA(1, 0), a3, voffA);
            PG8_BAR; PG8_WAIT_L(0); PG8_MMA(1, 0, At, B0); PG8_BAR; PG8_SCHED;
            PG8_STAGE(PG8_SB(1, 1), b3 + hstep, voffB);
            PG8_WAIT_V(6); PG8_BAR; PG8_MMA(1, 1, At, B1); PG8_BAR;
            }
        }
        if constexpr (F8) asm volatile("s_nop 15\n\ts_nop 15" ::: "memory");
        if constexpr (ALIGN_EPI) { if (wr == 0) PG8_BAR; }
        if constexpr (!Epi::AFTER_DRAIN) { E(acc, cur, wr, wc, fr, fq); S.done(cur); }
        if (!has_next) break;
#pragma unroll
        for (int a = 0; a < 2; ++a)
#pragma unroll
            for (int b = 0; b < 2; ++b)
#pragma unroll
                for (int m = 0; m < 4; ++m)
#pragma unroll
                    for (int n = 0; n < 2; ++n) acc[a][b][m][n] = (f32x4){zf_, zf_, zf_, zf_};
        cur = nxt; cA = nA; cB = nB; ++ui;
        if constexpr (ALIGN_EPI) { if (wr == 1) PG8_BAR; }
    }
    PG8_WAIT_V(0);
    if constexpr (!ALIGN_EPI) { if (wr == 0) PG8_BAR; }
    PG8_BAR;
    if constexpr (Epi::AFTER_DRAIN) { E.fused(acc, cur, wr, wc, fr, fq, lds, wid, lane); S.done(cur); }
#undef PG8_SA
#undef PG8_SB
#undef PG8_STAGE
#undef PG8_LD8
#undef PG8_LDA
#undef PG8_LDB
#undef PG8_MMA
#undef PG8_WAIT_V
#undef PG8_WAIT_L
#undef PG8_BAR
#undef PG8_SCHED
}
}

using pg8::bf16_t; using pg8::bf16x8; using pg8::f32x4; using pg8::u32x4; using pg8::f32x2; using pg8::Unit;

#ifndef DBG_STOP_AFTER
#define DBG_STOP_AFTER 1000
#endif
#ifndef R1_GLOBAL_W
#define R1_GLOBAL_W 0
#endif
#ifndef R1_SIMPLE
#define R1_SIMPLE 0
#endif
constexpr int NB = 8, SEQ = 4096, LC = 256, DM = 1024, PBR = LC + SEQ  , TR = NB * PBR  , NTILE = TR / 256  , TPB = PBR / 256  ;
constexpr int DIN = 7168, NLAYER = 2, NEXP = 16, NWAVES = 8, NCOND = 9  , MODW = 6 * DM;
constexpr float EPSN = 1e-6f;
constexpr int N_PHASES = 2 + 9 * NLAYER;
constexpr int MAXBLK = 2 * TR / 256 + NEXP;
constexpr size_t PART_ELEMS = (size_t)TR * DM;

constexpr size_t MiB = 1u << 20;
constexpr size_t WS_CTL = 0, CTL_ZERO_BYTES = 1 * MiB;
constexpr size_t WS_MODV = 1 * MiB;
constexpr size_t WS_COS = 2 * MiB, WS_SIN = 2 * MiB + 512 * 1024;
constexpr size_t WS_LAM = 3 * MiB;
constexpr size_t WS_TOKINFO = 3 * MiB + 65536;
constexpr size_t WS_TOKSLOT = 4 * MiB;
constexpr size_t WS_CNT = 4 * MiB + 512 * 1024;
constexpr size_t WS_BLKTAB = WS_CNT + 65536;
constexpr size_t WS_TOKGATE = 5 * MiB;
constexpr size_t WS_TOKC = 5 * MiB + 512 * 1024;
constexpr size_t WS_XC = 8 * MiB;
constexpr size_t WS_WMIX = 16 * MiB, WMIX_LAYER = 21 * MiB;
constexpr size_t WM_WIN = 0, WM_WR = 14 * MiB, WM_WA = 16 * MiB, WM_WO = 18 * MiB, WM_LRU = 20 * MiB;
constexpr size_t WS_HA = 58 * MiB;
constexpr size_t WS_PARTS = 126 * MiB;
constexpr size_t WS_GATES = WS_PARTS + 5 * 68 * MiB, GATE_BYTES = (size_t)TR * DM;
constexpr size_t WS_XB = WS_PARTS, WS_ACT = WS_PARTS + 144 * MiB;
constexpr size_t WS_W13 = WS_PARTS + 6 * 68 * MiB, WS_W2 = WS_W13 + 32 * MiB;
constexpr size_t WS_END = WS_W13 + 96 * MiB;
constexpr size_t F8_TILE = 256 * (size_t)DM;
static_assert(PART_ELEMS * 2 == 68 * MiB && WS_ACT + 72 * MiB <= WS_W13 && (size_t)MAXBLK * 256 * 2048 == 144 * MiB && WS_END == 630 * MiB, "ws map");
static_assert(WS_XB % F8_TILE == 0 && WS_ACT % F8_TILE == 0 && WS_W13 % F8_TILE == 0 && WS_W2 % F8_TILE == 0, "tile-addressed regions");
constexpr int CW_TMO = 0, CW_BAR = 4096, CW_QUEUE = 8192;

constexpr int RING_BYTES = 131072, LDSCTL_OFF = RING_BYTES, MISC_OFF = LDSCTL_OFF + 320, TAB_OFF = LDSCTL_OFF + 1024, LDS_BYTES = 147456;

#define LDS_WAIT() asm volatile("s_waitcnt lgkmcnt(0)" ::: "memory")
#define VM_WAIT() asm volatile("s_waitcnt vmcnt(0)" ::: "memory")
#define SBAR() __builtin_amdgcn_sched_barrier(0)
__device__ __forceinline__ unsigned f2bf(float f) { unsigned u = __builtin_bit_cast(unsigned, f); return (u + 0x7fffu + ((u >> 16) & 1u)) >> 16; }
__device__ __forceinline__ unsigned pk2(float lo, float hi) { return f2bf(lo) | (f2bf(hi) << 16); }
__device__ __forceinline__ float bflo(unsigned w) { return __builtin_bit_cast(float, w << 16); }
__device__ __forceinline__ float bfhi(unsigned w) { return __builtin_bit_cast(float, w & 0xffff0000u); }
__device__ __forceinline__ float fast_sigmoid(float x) { return __builtin_amdgcn_rcpf(1.f + __builtin_amdgcn_exp2f(-1.4426950408889634f * x)); }
__device__ __forceinline__ float gelu_tanh(float x) { return x * fast_sigmoid(1.5957691216057308f * (x + 0.044715f * x * x * x)); }
__device__ __forceinline__ unsigned pk4_fp8(float a, float b, float c, float d) { unsigned w = 0u; w = __builtin_amdgcn_cvt_pk_fp8_f32(a, b, w, false); w = __builtin_amdgcn_cvt_pk_fp8_f32(c, d, w, true); return w; }
__device__ __forceinline__ unsigned ld_dev(const void* p) { return __hip_atomic_load((const unsigned*)p, __ATOMIC_RELAXED, __HIP_MEMORY_SCOPE_AGENT); }
__device__ __forceinline__ float ld_devf(const void* p) { return __builtin_bit_cast(float, ld_dev(p)); }
template <int CTRL, int ROW_MASK> __device__ __forceinline__ float dpp_add(float v) {
    return v + __builtin_bit_cast(float, __builtin_amdgcn_update_dpp(0, __builtin_bit_cast(int, v), CTRL, ROW_MASK, 0xF, false)); }
__device__ __forceinline__ float wave_sum(float v) {
    v = dpp_add<0xB1, 0xF>(v);
    v = dpp_add<0x4E, 0xF>(v);
    v = dpp_add<0x141, 0xF>(v);
    v = dpp_add<0x140, 0xF>(v);
    v = dpp_add<0x142, 0xA>(v);
    v = dpp_add<0x143, 0xC>(v);
    return __builtin_bit_cast(float, __builtin_amdgcn_readlane(__builtin_bit_cast(int, v), 63));
}

using pg8::cvt_pk_bf16;
constexpr float QSCALE = 0.125f * 1.4426950408889634f;
constexpr size_t WS_XBA = WS_PARTS + 238 * MiB, WS_XBB = WS_W13 + 48 * MiB;
static_assert(WS_XBA == WS_PARTS + 3 * 68 * MiB + 34 * MiB && WS_XBB + 34 * MiB <= WS_END && (size_t)(TR / 2) * DM * 2 == 34 * MiB && (TR / 2) % 256 == 0, "x bf16 halves");
__device__ __forceinline__ bf16_t* xb_row(unsigned char* ws, int R) { return (bf16_t*)(ws + (R < TR / 2 ? WS_XBA : WS_XBB)) + (size_t)(R < TR / 2 ? R : R - TR / 2) * DM; }
__device__ __forceinline__ int cond_of(int R) { const int b = R / PBR, p = R - b * PBR; return p < LC ? 8 : b; }
__device__ __forceinline__ f32x4 bf4(const u32x2 w) { return (f32x4){bflo(w.x), bfhi(w.x), bflo(w.y), bfhi(w.y)}; }
#ifndef G1_F8_PARTS
#define G1_F8_PARTS 0x6f
#endif
constexpr size_t WS_HA8 = WS_PARTS + 2 * 68 * MiB + 34 * MiB;
struct EpiG1 {
    static constexpr bool PERM = true, AFTER_DRAIN = false;
    bf16_t* parts; const float* cosT; const float* sinT; unsigned char* gates; int plain; float G1SC;
    __device__ __forceinline__ void operator()(const f32x4 (&acc)[2][2][4][2], const Unit& u, int wr, int wc, int fr, int fq) const {
        const int part = u.pn >> 2;
        bf16_t* base = parts + (size_t)part * PART_ELEMS;
        const int col0 = (u.pn & 3) * 256 + wc * 32 + 8 * fq;
        const int jt = u.pm % TPB, lrow0 = wr * 64 + fr, srow0 = (jt - 1) * 256 + lrow0;
        const size_t row0 = (size_t)u.pm * 256 + lrow0;
        const bool rope = (jt != 0) && (part == 1 || part == 3) && !plain;
        const int pair0 = (col0 & 63) >> 1;
        if (part == 2 && !plain) {
            unsigned char* vt = (unsigned char*)base + ((size_t)(u.pm / TPB) * DM + col0) * (68 * 64) + ((fr >> 2) & 1) * 32 + ((fr & 3) + 4 * (fr >> 3)) * 4;
#pragma unroll
            for (int ai = 0; ai < 2; ++ai)
#pragma unroll
                for (int bj = 0; bj < 2; ++bj) {
                    unsigned char* p = vt + (size_t)(bj * 128) * (68 * 64) + ((u.pm % TPB) * 4 + ai * 2 + wr) * 64;
#pragma unroll
                    for (int t = 0; t < 8; ++t) *(unsigned*)(p + (size_t)t * (68 * 64)) = pk4_fp8(acc[ai][bj][0][t >> 2][t & 3] * G1SC, acc[ai][bj][1][t >> 2][t & 3] * G1SC, acc[ai][bj][2][t >> 2][t & 3] * G1SC, acc[ai][bj][3][t >> 2][t & 3] * G1SC);
                }
            return;
        }
#pragma unroll
        for (int ai = 0; ai < 2; ++ai) {
            f32x4 csv[4], snv[4];
            if (rope) {
#pragma unroll
                for (int m = 0; m < 4; ++m) { const size_t to = (size_t)(srow0 + ai * 128 + m * 16) * 32 + pair0; csv[m] = *(const f32x4*)(cosT + to); snv[m] = *(const f32x4*)(sinT + to); }
            }
#pragma unroll
            for (int m = 0; m < 4; ++m) {
                const int dr = ai * 128 + m * 16;
                bf16_t* rowp = base + (row0 + dr) * DM + col0;
#pragma unroll
                for (int bj = 0; bj < 2; ++bj) {
                    f32x4 v0 = acc[ai][bj][m][0] * G1SC, v1 = acc[ai][bj][m][1] * G1SC;
                    if (rope) {
                        const f32x4 cs = csv[m], sn = snv[m];
                        v0 = (f32x4){v0[0] * cs[0] - v0[1] * sn[0], v0[0] * sn[0] + v0[1] * cs[0], v0[2] * cs[1] - v0[3] * sn[1], v0[2] * sn[1] + v0[3] * cs[1]};
                        v1 = (f32x4){v1[0] * cs[2] - v1[1] * sn[2], v1[0] * sn[2] + v1[1] * cs[2], v1[2] * cs[3] - v1[3] * sn[3], v1[2] * sn[3] + v1[3] * cs[3]};
                    } else if (plain) { if (part >= 5) continue;
                    } else if (part == 4) {
#pragma unroll
                        for (int t = 0; t < 4; ++t) { v0[t] = gelu_tanh(v0[t]); v1[t] = gelu_tanh(v1[t]); }
                    } else if (part >= 5) {
                        unsigned q[8];
#pragma unroll
                        for (int t = 0; t < 4; ++t) { q[t] = (unsigned)(fast_sigmoid(v0[t]) * 255.f + 0.5f); q[4 + t] = (unsigned)(fast_sigmoid(v1[t]) * 255.f + 0.5f); }
                        u32x2 w8; w8.x = q[0] | (q[1] << 8) | (q[2] << 16) | (q[3] << 24); w8.y = q[4] | (q[5] << 8) | (q[6] << 16) | (q[7] << 24);
                        *(u32x2*)(gates + (size_t)(part - 5) * GATE_BYTES + (row0 + dr) * DM + col0 + bj * 128) = w8;
                        continue;
                    }
                    if (part == 3) { v0 = v0 * QSCALE; v1 = v1 * QSCALE; }
                    if ((part == 1 || part == 3) && !plain) {
                        u32x2 w8; w8.x = pk4_fp8(v0[0], v0[1], v0[2], v0[3]); w8.y = pk4_fp8(v1[0], v1[1], v1[2], v1[3]);
                        *(u32x2*)((unsigned char*)(parts + PART_ELEMS) + (part == 3 ? GATE_BYTES : (size_t)0) + (row0 + dr) * DM + col0 + bj * 128) = w8;
                        continue;
                    }
                    u32x4 w; w.x = cvt_pk_bf16(v0[0], v0[1]); w.y = cvt_pk_bf16(v0[2], v0[3]); w.z = cvt_pk_bf16(v1[0], v1[1]); w.w = cvt_pk_bf16(v1[2], v1[3]);
                    *(u32x4*)(rowp + bj * 128) = w;
                }
            }
        }
    }
};
#ifndef G3_F8
#define G3_F8 0
#endif
struct EpiG2 {
    static constexpr bool PERM = true, AFTER_DRAIN = false;
    bf16_t* parts; const unsigned char* gates; float I255; unsigned char* m8;
    __device__ __forceinline__ void operator()(const f32x4 (&acc)[2][2][4][2], const Unit& u, int wr, int wc, int fr, int fq) const {
        const unsigned char* gate = gates + (size_t)u.sub * GATE_BYTES; bf16_t* mg = parts;
        const int col0 = u.pn * 256 + wc * 32 + 8 * fq; const size_t row0 = (size_t)u.pm * 256 + wr * 64 + fr;
        const unsigned smask = u.sub ? 0xffffffffu : 0u;
#pragma unroll
        for (int ai = 0; ai < 2; ++ai) {
            u32x2 g[4][2]; u32x4 t[4][2];
#pragma unroll
            for (int m = 0; m < 4; ++m)
#pragma unroll
                for (int bj = 0; bj < 2; ++bj) { const size_t off = (row0 + ai * 128 + m * 16) * DM + col0 + bj * 128;
                    g[m][bj] = *(const u32x2*)(gate + off); t[m][bj] = *(const u32x4*)(mg + off); }
#pragma unroll
            for (int m = 0; m < 4; ++m)
#pragma unroll
                for (int bj = 0; bj < 2; ++bj) { const size_t off = (row0 + ai * 128 + m * 16) * DM + col0 + bj * 128;
                    const u32x2 gg = g[m][bj]; u32x4 tt = t[m][bj]; tt.x &= smask; tt.y &= smask; tt.z &= smask; tt.w &= smask;
                    const f32x4 v0 = acc[ai][bj][m][0], v1 = acc[ai][bj][m][1];
                    const float r0 = v0[0] * ((float)(gg.x & 255u) * I255) + bflo(tt.x), r1 = v0[1] * ((float)((gg.x >> 8) & 255u) * I255) + bfhi(tt.x);
                    const float r2 = v0[2] * ((float)((gg.x >> 16) & 255u) * I255) + bflo(tt.y), r3 = v0[3] * ((float)(gg.x >> 24) * I255) + bfhi(tt.y);
                    const float r4 = v1[0] * ((float)(gg.y & 255u) * I255) + bflo(tt.z), r5 = v1[1] * ((float)((gg.y >> 8) & 255u) * I255) + bfhi(tt.z);
                    const float r6 = v1[2] * ((float)((gg.y >> 16) & 255u) * I255) + bflo(tt.w), r7 = v1[3] * ((float)(gg.y >> 24) * I255) + bfhi(tt.w);
                    if (G3_F8 && u.sub) { u32x2 w8; w8.x = pk4_fp8(r0, r1, r2, r3); w8.y = pk4_fp8(r4, r5, r6, r7); *(u32x2*)(m8 + off) = w8; }
                    else { u32x4 w; w.x = cvt_pk_bf16(r0, r1); w.y = cvt_pk_bf16(r2, r3); w.z = cvt_pk_bf16(r4, r5); w.w = cvt_pk_bf16(r6, r7);
                    *(u32x4*)(mg + off) = w; } }
            asm volatile("" ::: "memory");
        }
    }
};
struct EpiG3 {
    static constexpr bool PERM = true, AFTER_DRAIN = false;
    unsigned char* ws; const float* modl; float scale;
    __device__ __forceinline__ void operator()(const f32x4 (&acc)[2][2][4][2], const Unit& u, int wr, int wc, int fr, int fq) const {
        const int b = u.pm / TPB, jt = u.pm % TPB;
        bf16_t* xt = xb_row(ws, u.pm * 256);
        const float* gt = modl + (size_t)(jt == 0 ? 8 : b) * MODW + 2 * DM;
        const int col0 = u.pn * 256 + wc * 32 + 8 * fq, lrow0 = wr * 64 + fr;
        f32x4 gv[2][2];
#pragma unroll
        for (int bj = 0; bj < 2; ++bj)
#pragma unroll
            for (int n = 0; n < 2; ++n) gv[bj][n] = *(const f32x4*)(gt + col0 + bj * 128 + n * 4) * scale;
#pragma unroll
        for (int ai = 0; ai < 2; ++ai) {
            u32x4 xv[4][2];
#pragma unroll
            for (int m = 0; m < 4; ++m)
#pragma unroll
                for (int bj = 0; bj < 2; ++bj) xv[m][bj] = *(const u32x4*)(xt + (size_t)(lrow0 + ai * 128 + m * 16) * DM + col0 + bj * 128);
#pragma unroll
            for (int m = 0; m < 4; ++m)
#pragma unroll
                for (int bj = 0; bj < 2; ++bj) { const u32x4 x = xv[m][bj]; const f32x4 a0 = gv[bj][0] * acc[ai][bj][m][0], a1 = gv[bj][1] * acc[ai][bj][m][1];
                    u32x4 w; w.x = cvt_pk_bf16(bflo(x.x) + a0[0], bfhi(x.x) + a0[1]); w.y = cvt_pk_bf16(bflo(x.y) + a0[2], bfhi(x.y) + a0[3]);
                    w.z = cvt_pk_bf16(bflo(x.z) + a1[0], bfhi(x.z) + a1[1]); w.w = cvt_pk_bf16(bflo(x.w) + a1[2], bfhi(x.w) + a1[3]);
                    *(u32x4*)(xt + (size_t)(lrow0 + ai * 128 + m * 16) * DM + col0 + bj * 128) = w; }
            asm volatile("" ::: "memory");
        }
    }
};
constexpr float WSC = 1.f / 32.f;
struct EpiE1 {
    static constexpr bool PERM = true, AFTER_DRAIN = false;
    unsigned char* act;
    __device__ __forceinline__ void operator()(const f32x4 (&acc)[2][2][4][2], const Unit& u, int wr, int wc, int fr, int fq) const {
        const int col0 = u.pn * 128 + wc * 32 + 8 * fq; const size_t row0 = (size_t)u.pm * 256 + wr * 64 + fr;
#pragma unroll
        for (int ai = 0; ai < 2; ++ai)
#pragma unroll
            for (int m = 0; m < 4; ++m) {
                const f32x4 a0 = acc[ai][0][m][0], a1 = acc[ai][0][m][1], b0 = acc[ai][1][m][0], b1 = acc[ai][1][m][1];
                float r[8];
#pragma unroll
                for (int t = 0; t < 4; ++t) { const float x0 = a0[t] * WSC, x1 = a1[t] * WSC; r[t] = x0 * fast_sigmoid(x0) * (b0[t] * WSC); r[4 + t] = x1 * fast_sigmoid(x1) * (b1[t] * WSC); }
                u32x2 w; w.x = pk4_fp8(r[0], r[1], r[2], r[3]); w.y = pk4_fp8(r[4], r[5], r[6], r[7]);
                *(u32x2*)(act + (row0 + ai * 128 + m * 16) * DM + col0) = w;
            }
    }
};
constexpr float YSC = 8.f;
struct EpiE2 {
    static constexpr bool PERM = true, AFTER_DRAIN = false;
    unsigned char* y; int nostore;
    __device__ __forceinline__ void operator()(const f32x4 (&acc)[2][2][4][2], const Unit& u, int wr, int wc, int fr, int fq) const {
        const int col0 = u.pn * 256 + wc * 32 + 8 * fq; const size_t row0 = (size_t)u.pm * 256 + wr * 64 + fr;
#pragma unroll
        for (int ai = 0; ai < 2; ++ai)
#pragma unroll
            for (int m = 0; m < 4; ++m)
#pragma unroll
                for (int bj = 0; bj < 2; ++bj) {
                    const f32x4 v0 = acc[ai][bj][m][0] * (WSC * YSC), v1 = acc[ai][bj][m][1] * (WSC * YSC);
                    u32x2 w; w.x = pk4_fp8(v0[0], v0[1], v0[2], v0[3]); w.y = pk4_fp8(v1[0], v1[1], v1[2], v1[3]);
                    if (!nostore) *(u32x2*)(y + (row0 + ai * 128 + m * 16) * DM + col0 + bj * 128) = w; else asm volatile("" :: "v"(w));
                }
    }
};
struct OrderG2 { int G, c; bool noctx; int sub; bool f8;
    __device__ __forceinline__ bool next(int i, Unit& u) const { const int L = i * G + c; if (L >= (noctx ? NB * 16 : NTILE) * 4) return false;
        const int t = L >> 2; u.pm = noctx ? (t >> 4) * TPB + 1 + (t & 15) : t; u.pn = L & 3; u.sub = sub;
        if (f8) { u.pa = (sub ? 3 : 4) * (2 * NTILE) + u.pm; u.pb = sub * 8 + u.pn; }
        else { u.pa = (sub ? 3 : 4) * NTILE + u.pm; u.pb = sub * 4 + u.pn; } return true; }
    __device__ __forceinline__ void a_ready(const Unit&) const {}
    __device__ __forceinline__ void done(const Unit&) const {}
};
struct OrderG1 { int G, c, np; unsigned plist; bool f8;
    __device__ __forceinline__ bool next(int i, Unit& u) const { using namespace pg8;
        const int nN = 4 * np, nwg = NTILE * nN, L = i * G + c; if (L >= nwg) return false;
        int wgid = L; { const int q = nwg / NXCD, r = nwg % NXCD, xcd = wgid % NXCD, off = wgid / NXCD; wgid = (xcd < r ? xcd * (q + 1) : r * (q + 1) + (xcd - r) * q) + off; }
        const int nig = WGM * nN, gid = wgid / nig, fm = gid * WGM, gsz = (NTILE - fm) < WGM ? (NTILE - fm) : WGM;
        u.pm = fm + ((wgid % nig) % gsz); const int ps = (wgid % nig) / gsz, part = (plist >> (4 * (ps >> 2))) & 15;
        u.pn = part * 4 + (ps & 3); u.pa = u.pm; u.pb = f8 ? part * 8 + (ps & 3) : u.pn; u.sub = 0; return true; }
    __device__ __forceinline__ void a_ready(const Unit&) const {}
    __device__ __forceinline__ void done(const Unit&) const {}
};
constexpr int g1_np(unsigned m) { int n = 0; for (int p = 0; p < 7; ++p) n += (m >> p) & 1; return n; }
constexpr unsigned g1_plist(unsigned m) { unsigned l = 0; int n = 0; for (int p = 0; p < 7; ++p) if ((m >> p) & 1) { l |= (unsigned)p << (4 * n); ++n; } return l; }
struct OrderG3 { int G, c; bool noctx;
    __device__ __forceinline__ bool next(int i, Unit& u) const { const int L = i * G + c; if (L >= (noctx ? NB * 16 : NTILE) * 4) return false;
        const int t = L >> 2; u.pm = noctx ? (t >> 4) * TPB + 1 + (t & 15) : t; u.pn = L & 3; u.sub = 0; u.pa = u.pm; u.pb = u.pn; return true; }
    __device__ __forceinline__ void a_ready(const Unit&) const {}
    __device__ __forceinline__ void done(const Unit&) const {}
};
struct OrderE { int G, c, nblk, ng; const LAS int* tab; int a_t0, b_t0;
    __device__ __forceinline__ bool next(int i, Unit& u) const { const int L = i * G + c; if (L >= nblk * ng) return false;
        const int blk = L / ng, g = L - blk * ng, e = __builtin_amdgcn_readfirstlane(tab[blk]);
        u.pm = blk; u.pn = g; u.sub = 0; u.pa = a_t0 + blk; u.pb = b_t0 + e * ng + g; return true; }
    __device__ __forceinline__ void a_ready(const Unit&) const {}
    __device__ __forceinline__ void done(const Unit&) const {}
};

#define XB_TMO      128
#define XB_XCNT(j)  (256  + 64 * (j))
#define XB_XSUB(j)  (1280 + 64 * (j))
#define XB_XGEN(j)  (2304 + 64 * (j))
#define XB_TOP      3328
#define XB_TOPGEN   3392
#define XCD_BAR_WORDS 3456
#define XB_SPIN_CAP (1u << 18)

__device__ __forceinline__ unsigned xb_ld(unsigned* p)              { return __hip_atomic_load(p, __ATOMIC_RELAXED, __HIP_MEMORY_SCOPE_AGENT); }
__device__ __forceinline__ unsigned xb_add(unsigned* p, unsigned v) { return __hip_atomic_fetch_add(p, v, __ATOMIC_RELAXED, __HIP_MEMORY_SCOPE_AGENT); }
__device__ __forceinline__ unsigned xb_xcc_id() { return (unsigned)__builtin_amdgcn_s_getreg((3 << 11) | 20) & 0xFu; }
#define XB_SPIN(cond, bar) do { unsigned _sp = 0; while (cond) { __builtin_amdgcn_s_sleep(1); \
    if ((++_sp & 255u) == 0u) { if (xb_ld(&(bar)[XB_TMO])) break; if (_sp > XB_SPIN_CAP) { atomicAdd(&(bar)[XB_TMO], 1u); break; } } } } while (0)

struct XcdBarrier {
    unsigned* bar; unsigned x;
    volatile LAS unsigned* st;
};
__device__ __forceinline__ XcdBarrier xcd_barrier_post(unsigned* bar, volatile LAS unsigned* st) {
    XcdBarrier b; b.bar = bar; b.x = xb_xcc_id(); b.st = st;
    if (threadIdx.x == 0) (void)xb_add(&bar[XB_XCNT(b.x)], 1u);
    return b;
}
__device__ __forceinline__ void xcd_barrier_complete(unsigned* bar, unsigned x, unsigned& nloc, unsigned& nx) {
    const unsigned G = gridDim.x * gridDim.y * gridDim.z;
    unsigned sum, cnt, mine, sp = 0u;
    for (;;) {
        sum = 0u; cnt = 0u; mine = 0u;
#pragma unroll
        for (unsigned j = 0; j < 16; ++j) { const unsigned c = xb_ld(&bar[XB_XCNT(j)]); sum += c; cnt += (c > 0u) ? 1u : 0u; mine = (j == x) ? c : mine; }
        if (sum == G) break;
        __builtin_amdgcn_s_sleep(1);
        if ((++sp & 255u) == 0u) { if (xb_ld(&bar[XB_TMO])) break; if (sp > XB_SPIN_CAP) { atomicAdd(&bar[XB_TMO], 1u); break; } }
    }
    nloc = mine > 0u ? mine : 1u; nx = cnt > 0u ? cnt : 1u;
}
__device__ __forceinline__ void xcd_barrier(const XcdBarrier& b) {
    asm volatile("s_waitcnt vmcnt(0)" ::: "memory");
    __syncthreads();
    if (threadIdx.x == 0) {
        unsigned* bar = b.bar;
        __builtin_amdgcn_s_waitcnt(0);
        unsigned nloc = b.st[0], nx = b.st[1];
        if (nloc == 0u) { xcd_barrier_complete(bar, b.x, nloc, nx); b.st[0] = nloc; b.st[1] = nx; }
        const unsigned old = xb_add(&bar[XB_XSUB(b.x)], 1u);
        const unsigned gen = old / nloc;
        if (old + 1u == (gen + 1u) * nloc) {
            __builtin_amdgcn_fence(__ATOMIC_RELEASE, "agent");
            asm volatile("s_waitcnt vmcnt(0)" ::: "memory");
            const unsigned og = xb_add(&bar[XB_TOP], 1u);
            const unsigned tg = og / nx;
            if (og + 1u == (tg + 1u) * nx) xb_add(&bar[XB_TOPGEN], 1u);
            else XB_SPIN(xb_ld(&bar[XB_TOPGEN]) == tg, bar);
            __builtin_amdgcn_fence(__ATOMIC_ACQUIRE, "agent");
            xb_add(&bar[XB_XGEN(b.x)], 1u);
            asm volatile("s_waitcnt vmcnt(0)" ::: "memory");
        } else {
            XB_SPIN(xb_ld(&bar[XB_XGEN(b.x)]) == gen, bar);
            __builtin_amdgcn_fence(__ATOMIC_ACQUIRE, "agent");
            asm volatile("s_waitcnt vmcnt(0)" ::: "memory");
        }
    }
    __syncthreads();
}

struct Args { const float* in[27]; float* out; unsigned char* ws; int ph_lo, ph_hi; };
typedef const __attribute__((address_space(4))) Args* KArgs;
__device__ __forceinline__ KArgs kargs() { KArgs p = (KArgs)__builtin_amdgcn_kernarg_segment_ptr(); asm volatile("" : "+s"(p)); return p; }
struct Frame {
    LAS unsigned char* lds; unsigned char* ldsg;
    volatile LAS unsigned* MISC;
    unsigned* ctl; unsigned char* ws; float* out;
    int tid, lane, wave, vcu, G;
};
enum { I_X = 0, I_C, I_CTX, I_CCTX, I_WMOD, I_BMOD, I_GN1, I_GN2, I_WIN, I_CONVW, I_CONVB, I_LWA, I_LBA, I_LWX, I_LBX, I_LLAM, I_DLAM, I_GSUB, I_WRNN, I_WATT, I_WO, I_WROUT, I_BROUT, I_WE1, I_WE3, I_WE2, I_GFIN };

struct TrRegs { f32x4 v[8]; };
__device__ __forceinline__ void tr_load(TrRegs& t, const float* W, int N, int k0, int n0, int lane) {
#pragma unroll
    for (int i = 0; i < 8; ++i) t.v[i] = *(const f32x4*)(W + (size_t)(k0 + 8 * i + (lane >> 3)) * N + n0 + 4 * (lane & 7));
}
template <bool F8> __device__ __forceinline__ void tr_store(const TrRegs& t, int K, int k0, void* WTrow0, LAS float* scr, int lane) {
    constexpr float sc = F8 ? 32.f : 1.f;
#pragma unroll
    for (int i = 0; i < 8; ++i) { LAS float* d = scr + (8 * i + (lane >> 3)) * 33 + 4 * (lane & 7); d[0] = t.v[i][0] * sc; d[1] = t.v[i][1] * sc; d[2] = t.v[i][2] * sc; d[3] = t.v[i][3] * sc; }
    LDS_WAIT(); asm volatile("" ::: "memory");
    const int c = lane & 7;
#pragma unroll
    for (int j = 0; j < 4; ++j) { const int n = (lane >> 3) + 8 * j; const LAS float* s = scr + (8 * c) * 33 + n;
        if constexpr (F8) { u32x2 o; o.x = pk4_fp8(s[0 * 33], s[1 * 33], s[2 * 33], s[3 * 33]); o.y = pk4_fp8(s[4 * 33], s[5 * 33], s[6 * 33], s[7 * 33]);
            *(u32x2*)((unsigned char*)WTrow0 + (size_t)n * K + k0 + 8 * c) = o; }
        else { u32x4 o; o.x = pk2(s[0 * 33], s[1 * 33]); o.y = pk2(s[2 * 33], s[3 * 33]); o.z = pk2(s[4 * 33], s[5 * 33]); o.w = pk2(s[6 * 33], s[7 * 33]);
            *(u32x4*)((bf16_t*)WTrow0 + (size_t)n * K + k0 + 8 * c) = o; } }
    LDS_WAIT(); asm volatile("" ::: "memory");
}
__device__ __forceinline__ void transpose_item(const float* W, int N, int K, int k0, int n0, bf16_t* WTrow0, LAS float* scr, int lane) { TrRegs t; tr_load(t, W, N, k0, n0, lane); tr_store<false>(t, K, k0, WTrow0, scr, lane); }
__device__ __forceinline__ void transpose_item_f8(const float* W, int N, int K, int k0, int n0, unsigned char* WTrow0, LAS float* scr, int lane) { TrRegs t; tr_load(t, W, N, k0, n0, lane); tr_store<true>(t, K, k0, WTrow0, scr, lane); }
constexpr int T_WIN = (DM / 64) * (DIN / 32), T_P = (DM / 64) * (DM / 32), T_LRU = 2 * 8 * 2 * 8, T_LAYER = T_WIN + 3 * T_P + T_LRU;
struct TrW { f32x4 v[8]; };
__device__ __forceinline__ void trw_load(TrW& t, const float* W, int N, int k0, int n0, int tid) {
#pragma unroll
    for (int i = 0; i < 8; ++i) t.v[i] = *(const f32x4*)(W + (size_t)(k0 + 8 * (tid >> 6) + i) * N + n0 + 4 * (tid & 63));
}
template <bool F8, class RowFn> __device__ __forceinline__ void trw_store(const TrW& t, int k0, const RowFn& dstrow  , LAS unsigned char* lds, int tid) {
    constexpr float sc = F8 ? 32.f : 1.f; LAS float* scr = (LAS float*)lds;
#pragma unroll
    for (int i = 0; i < 8; ++i) *(LAS f32x4*)(scr + (8 * (tid >> 6) + i) * 260 + 4 * (tid & 63)) = t.v[i] * sc;
    __syncthreads();
    const int n = tid >> 1, hf = tid & 1; const LAS float* s = scr + (32 * hf) * 260 + n; unsigned char* d = dstrow(n);
    if constexpr (F8) { u32x4 o[2];
#pragma unroll
        for (int q = 0; q < 8; ++q) { const unsigned w = pk4_fp8(s[(4 * q) * 260], s[(4 * q + 1) * 260], s[(4 * q + 2) * 260], s[(4 * q + 3) * 260]); if (q < 4) o[0][q] = w; else o[1][q - 4] = w; }
        u32x4* dp = (u32x4*)(d + k0 + 32 * hf); dp[0] = o[0]; dp[1] = o[1]; }
    else { u32x4 o[4];
#pragma unroll
        for (int q = 0; q < 16; ++q) o[q >> 2][q & 3] = pk2(s[(2 * q) * 260], s[(2 * q + 1) * 260]);
        u32x4* dp = (u32x4*)(d + (size_t)(k0 + 32 * hf) * 2); dp[0] = o[0]; dp[1] = o[1]; dp[2] = o[2]; dp[3] = o[3]; }
    __syncthreads();
}
struct RowLin { unsigned char* base; size_t pitch; __device__ __forceinline__ unsigned char* operator()(int n) const { return base + (size_t)n * pitch; } };
constexpr int TW_WIN = (DM / 64) * (DIN / 256), TW_P = (DM / 64) * (DM / 256), TW_LAYER = TW_WIN + 3 * TW_P;
struct TrWGeom { const float* W; int N, k0, n0; RowLin row; bool f8; };
struct TrGeom { const float* W; int N, K, k0, n0; void* dst; bool f8; };
__device__ __forceinline__ TrGeom mixer_transpose_geom(const Frame& F, KArgs A, int l, int t) {
    unsigned char* wl = F.ws + WS_WMIX + (size_t)l * WMIX_LAYER; TrGeom g;
    if (t < T_WIN) { const int nblk = DIN / 32, kb = t / nblk, nb = t % nblk;
        const int part = nb >> 5;
        g.W = A->in[I_WIN] + (size_t)l * DM * DIN; g.N = DIN; g.K = DM; g.k0 = 64 * kb; g.n0 = 32 * nb; g.f8 = (G1_F8_PARTS >> part) & 1;
        g.dst = g.f8 ? (void*)(wl + WM_WIN + (size_t)part * (2 * MiB) + (size_t)(32 * nb - 1024 * part) * DM) : (void*)((bf16_t*)(wl + WM_WIN) + (size_t)(32 * nb) * DM);
        return g; }
    t -= T_WIN;
    if (t < 3 * T_P) { const int which = t / T_P, tt = t % T_P, nblk = DM / 32, kb = tt / nblk, nb = tt % nblk;
        g.W = A->in[which == 0 ? I_WRNN : (which == 1 ? I_WATT : I_WO)] + (size_t)l * DM * DM; g.N = DM; g.K = DM; g.k0 = 64 * kb; g.n0 = 32 * nb; g.f8 = (which == 1 || (which == 2 && G3_F8));
        g.dst = g.f8 ? (void*)(wl + (which == 1 ? WM_WA : WM_WO) + (size_t)(32 * nb) * DM) : (void*)((bf16_t*)(wl + (which == 0 ? WM_WR : WM_WO)) + (size_t)(32 * nb) * DM);
        return g; }
    t -= 3 * T_P;
    { const int mat = t >> 3, item = t & 7, d = mat >> 4, blk = (mat >> 1) & 7, ax = mat & 1, kb = item >> 2, nb = item & 3;
        g.W = A->in[ax ? I_LWX : I_LWA] + ((size_t)(l * 2 + d) * 8 + blk) * 128 * 128; g.N = 128; g.K = 128; g.k0 = 64 * kb; g.n0 = 32 * nb; g.f8 = false;
        g.dst = (void*)((bf16_t*)(wl + WM_LRU) + ((size_t)(d * 8 + blk) * 256 + ax * 128 + 32 * nb) * 128); }
    return g;
}
__device__ __forceinline__ void mixer_transpose_item(const Frame& F, KArgs A, int l, int t, LAS float* scr, const int lane) {
    const TrGeom g = mixer_transpose_geom(F, A, l, t); TrRegs r; tr_load(r, g.W, g.N, g.k0, g.n0, lane);
    if (g.f8) tr_store<true>(r, g.K, g.k0, g.dst, scr, lane); else tr_store<false>(r, g.K, g.k0, g.dst, scr, lane);
}
__device__ __forceinline__ TrWGeom mixer_trw_geom(const Frame& F, KArgs A, int l, int t) {
    unsigned char* wl = F.ws + WS_WMIX + (size_t)l * WMIX_LAYER; TrWGeom g;
    if (t < TW_WIN) { const int nblk = DIN / 256, kb = t / nblk, nb = t % nblk, part = nb >> 2;
        g.W = A->in[I_WIN] + (size_t)l * DM * DIN; g.N = DIN; g.k0 = 64 * kb; g.n0 = 256 * nb; g.f8 = (G1_F8_PARTS >> part) & 1;
        g.row = g.f8 ? RowLin{wl + WM_WIN + (size_t)part * (2 * MiB) + (size_t)(256 * nb - 1024 * part) * DM, (size_t)DM} : RowLin{wl + WM_WIN + (size_t)(256 * nb) * DM * 2, (size_t)DM * 2};
        return g; }
    t -= TW_WIN;
    { const int which = t / TW_P, tt = t % TW_P, kb = tt / 4, nb = tt % 4;
        g.W = A->in[which == 0 ? I_WRNN : (which == 1 ? I_WATT : I_WO)] + (size_t)l * DM * DM; g.N = DM; g.k0 = 64 * kb; g.n0 = 256 * nb; g.f8 = (which == 1 || (which == 2 && G3_F8));
        g.row = g.f8 ? RowLin{wl + (which == 1 ? WM_WA : WM_WO) + (size_t)(256 * nb) * DM, (size_t)DM} : RowLin{wl + (which == 0 ? WM_WR : WM_WO) + (size_t)(256 * nb) * DM * 2, (size_t)DM * 2}; }
    return g;
}
__device__ __forceinline__ void mixer_conv_unit(const Frame& F0, KArgs, int cu) {
    KArgs A = kargs(); Frame F = F0; F.ws = A->ws;
    LAS float* scr = (LAS float*)(F.lds + F.wave * 8704);
    int ln = F.lane; asm volatile("" : "+v"(ln));
    for (int j = 0; j < 6; ++j) mixer_transpose_item(F, A, 1, cu * 48 + F.wave * 6 + j, scr, ln);
    __syncthreads();
}
__device__ __forceinline__ void p0_phase(const Frame& F, KArgs A, int skip = 0) {
    LAS float* sil = (LAS float*)(F.lds + 73728);
    for (int i = F.tid; i < NCOND * DM; i += NWAVES * 64) { const int r = i >> 10, k = i & 1023; const float c = r < 8 ? A->in[I_C][r * DM + k] : A->in[I_CCTX][k]; sil[i] = c / (1.f + expf(-c)); }
    __syncthreads();
    const int gw = F.vcu * NWAVES + F.wave, NGW = F.G * NWAVES, lane = F.lane;
    constexpr int N_ADA = NLAYER * (MODW / 64);
    if (skip != 1) {   LAS float* red = (LAS float*)(F.lds + 112640);
        for (int it = F.vcu; it < N_ADA; it += F.G) {
            const int l = it / (MODW / 64), col = (it % (MODW / 64)) * 64 + lane;
            const float* w = A->in[I_WMOD] + ((size_t)l * DM + F.wave * 128) * MODW + col;
            float acc[NCOND];
#pragma unroll
            for (int q = 0; q < NCOND; ++q) acc[q] = 0.f;
#pragma unroll 16
            for (int k = 0; k < 128; ++k) { const float wv = w[(size_t)k * MODW];
#pragma unroll
                for (int q = 0; q < NCOND; ++q) acc[q] += sil[q * DM + F.wave * 128 + k] * wv; }
#pragma unroll
            for (int q = 0; q < NCOND; ++q) red[(F.wave * NCOND + q) * 64 + lane] = acc[q];
            __syncthreads();
            for (int o = F.tid; o < NCOND * 64; o += NWAVES * 64) { const int q = o >> 6, cl = o & 63; float s = 0.f;
#pragma unroll
                for (int wv = 0; wv < NWAVES; ++wv) s += red[(wv * NCOND + q) * 64 + cl];
                const int cc = (it % (MODW / 64)) * 64 + cl;
                ((float*)(F.ws + WS_MODV))[((size_t)l * NCOND + q) * MODW + cc] = s + A->in[I_BMOD][l * MODW + cc]; }
            __syncthreads();
        }
    }
    LAS float* scr = (LAS float*)(F.lds + F.wave * 8704);
    constexpr int N_TR = NLAYER * T_LAYER, N_ROPE = SEQ * 32 / 64, N_TOT = N_TR + N_ROPE + 1;
    if (skip != 2) {
        __syncthreads();
        constexpr int N_TW = NLAYER * TW_LAYER;
        TrW tw[2]; if (F.vcu < N_TW) { const TrWGeom g = mixer_trw_geom(F, A, F.vcu / TW_LAYER, F.vcu % TW_LAYER); trw_load(tw[0], g.W, g.N, g.k0, g.n0, F.tid); }
#pragma unroll
        for (int j = 0; j < 5; ++j) { const int it = F.vcu + j * F.G, nx = it + F.G;
            if (j + 1 < 5 && nx < N_TW) { const TrWGeom g = mixer_trw_geom(F, A, nx / TW_LAYER, nx % TW_LAYER); trw_load(tw[(j + 1) & 1], g.W, g.N, g.k0, g.n0, F.tid); }
            if (it < N_TW) { const TrWGeom g = mixer_trw_geom(F, A, it / TW_LAYER, it % TW_LAYER);
                if (g.f8) trw_store<true>(tw[j & 1], g.k0, g.row, F.lds, F.tid); else trw_store<false>(tw[j & 1], g.k0, g.row, F.lds, F.tid); } }
        for (int it = F.vcu + 5 * F.G; it < N_TW; it += F.G) {
            const TrWGeom g = mixer_trw_geom(F, A, it / TW_LAYER, it % TW_LAYER); TrW t1; trw_load(t1, g.W, g.N, g.k0, g.n0, F.tid);
            if (g.f8) trw_store<true>(t1, g.k0, g.row, F.lds, F.tid); else trw_store<false>(t1, g.k0, g.row, F.lds, F.tid); }
        for (int it = gw; it < NLAYER * T_LRU; it += NGW) mixer_transpose_item(F, A, it / T_LRU, T_WIN + 3 * T_P + it % T_LRU, scr, lane);
    }
    for (int it = gw; it < N_TOT; it += NGW) {
        int r = it;
        if (r < N_TR) continue;
        r -= N_TR;
        if (r < N_ROPE) { const int idx = r * 64 + lane, s = idx >> 5, i = idx & 31, j = i & 15;
            const float inv = powf(10000.f, -(float)j / 16.f), pos = (float)(i < 16 ? (s >> 6) : (s & 63)), ang = pos * inv;
            ((float*)(F.ws + WS_COS))[idx] = cosf(ang); ((float*)(F.ws + WS_SIN))[idx] = sinf(ang); continue; }
        {
            float* lams = (float*)(F.ws + WS_LAM);
            for (int l = 0; l < NLAYER; ++l) { const float* dl = A->in[I_DLAM] + l * 256;
                const float s1 = wave_sum(dl[lane] * dl[64 + lane]), s2 = wave_sum(dl[128 + lane] * dl[192 + lane]);
                const float lam_init = 0.8f - 0.6f * expf(-0.3f * (float)l);
                if (lane == 0) { lams[l * 2] = expf(s1) - expf(s2) + lam_init; lams[l * 2 + 1] = 1.f - lam_init; } }
        }
    }
}

__device__ __forceinline__ float* xrow_ptr(const Frame& F, int R, int& cond) {
    const int b = R / PBR, p = R - b * PBR;
    if (p < LC) { cond = 8; return (float*)(F.ws + WS_XC) + ((size_t)b * LC + p) * DM; }
    cond = b; return F.out + ((size_t)b * SEQ + (p - LC)) * DM;
}
struct YRows { unsigned a[4], b[4]; float g1; bool on; };
__device__ __forceinline__ u32x4 tokc_load(const Frame& F, int R) { const unsigned* p = (const unsigned*)((const u32x4*)(F.ws + WS_TOKC) + R); u32x4 t; t.x = ld_dev(p); t.y = ld_dev(p + 1); t.z = ld_dev(p + 2); t.w = ld_dev(p + 3); return t; }
__device__ __forceinline__ void y_load(const Frame& F, const u32x4 t, YRows& y, int R) {
    y.on = t.w != 0u; y.g1 = ld_devf((const float*)(F.ws + WS_TOKGATE) + R);
    const unsigned char* y1 = F.ws + WS_XB + (size_t)(y.on ? t.x : 0u) * DM, *y2 = F.ws + WS_XB + (size_t)(y.on ? t.y : 0u) * DM;
#pragma unroll
    for (int j = 0; j < 4; ++j) { const int c = 256 * j + 4 * F.lane; y.a[j] = *(const unsigned*)(y1 + c); y.b[j] = *(const unsigned*)(y2 + c); }
}
__device__ __forceinline__ void combine_apply(const Frame& F, const YRows& y, int cond, int ylayer, f32x4 (&v)[4]) {
    if (!y.on) return;
    const float g1 = y.g1 * (1.f / YSC), g2 = (1.f - y.g1) * (1.f / YSC);
    const float* gt2 = (const float*)(F.ws + WS_MODV) + ((size_t)ylayer * NCOND + cond) * MODW + 5 * DM;
#pragma unroll
    for (int j = 0; j < 4; ++j) { const int c = 256 * j + 4 * F.lane; const int a = (int)y.a[j], b = (int)y.b[j]; const f32x4 g = *(const f32x4*)(gt2 + c);
        v[j][0] += g[0] * (g1 * __builtin_amdgcn_cvt_f32_fp8(a, 0) + g2 * __builtin_amdgcn_cvt_f32_fp8(b, 0)); v[j][1] += g[1] * (g1 * __builtin_amdgcn_cvt_f32_fp8(a, 1) + g2 * __builtin_amdgcn_cvt_f32_fp8(b, 1));
        v[j][2] += g[2] * (g1 * __builtin_amdgcn_cvt_f32_fp8(a, 2) + g2 * __builtin_amdgcn_cvt_f32_fp8(b, 2)); v[j][3] += g[3] * (g1 * __builtin_amdgcn_cvt_f32_fp8(a, 3) + g2 * __builtin_amdgcn_cvt_f32_fp8(b, 3)); }
}
__device__ __forceinline__ void n1_phase(const Frame& F, KArgs A, int l) {
    const int gw = F.vcu * NWAVES + F.wave, NGW = F.G * NWAVES, lane = F.lane;
    for (int R0 = gw; R0 < TR; R0 += 2 * NGW) {
        f32x4 v[2][4]; bf16_t* xp[2]; int cond[2]; bool ok[2]; YRows y[2];
#pragma unroll
        for (int u = 0; u < 2; ++u) { const int R = R0 + u * NGW; ok[u] = R < TR; const int Rc = ok[u] ? R : R0;
            xp[u] = xb_row(F.ws, Rc); cond[u] = cond_of(Rc);
            if (l == 0) { const int b = Rc / PBR, p = Rc - b * PBR; const float* src = p < LC ? A->in[I_CTX] + ((size_t)b * LC + p) * DM : A->in[I_X] + ((size_t)b * SEQ + (p - LC)) * DM;
#pragma unroll
                for (int j = 0; j < 4; ++j) v[u][j] = *(const f32x4*)(src + 256 * j + 4 * lane); }
            else {
#pragma unroll
                for (int j = 0; j < 4; ++j) v[u][j] = bf4(*(const u32x2*)(xp[u] + 256 * j + 4 * lane)); }
        }
        f32x4 gnv[4], shv[2][4], scv[2][4];
#pragma unroll
        for (int j = 0; j < 4; ++j) { const int c = 256 * j + 4 * lane; gnv[j] = *(const f32x4*)(A->in[I_GN1] + l * DM + c);
#pragma unroll
            for (int u = 0; u < 2; ++u) { const float* md = (const float*)(F.ws + WS_MODV) + ((size_t)l * NCOND + cond[u]) * MODW; shv[u][j] = *(const f32x4*)(md + c); scv[u][j] = *(const f32x4*)(md + DM + c); } }
        if (l > 0) { u32x4 t[2];
#pragma unroll
            for (int u = 0; u < 2; ++u) t[u] = tokc_load(F, ok[u] ? R0 + u * NGW : R0);
#pragma unroll
            for (int u = 0; u < 2; ++u) y_load(F, t[u], y[u], ok[u] ? R0 + u * NGW : R0);
        }
#pragma unroll
        for (int u = 0; u < 2; ++u) { if (!ok[u]) continue; const int R = R0 + u * NGW;
            if (l > 0) combine_apply(F, y[u], cond[u], l - 1, v[u]);
            float ss = 0.f;
#pragma unroll
            for (int j = 0; j < 4; ++j) { u32x2 xw; xw.x = pk2(v[u][j][0], v[u][j][1]); xw.y = pk2(v[u][j][2], v[u][j][3]); *(u32x2*)(xp[u] + 256 * j + 4 * lane) = xw; ss += (v[u][j][0] * v[u][j][0] + v[u][j][1] * v[u][j][1]) + (v[u][j][2] * v[u][j][2] + v[u][j][3] * v[u][j][3]); }
            const float rstd = 1.f / sqrtf(wave_sum(ss) * (1.f / DM) + EPSN);
            unsigned char* hp8 = F.ws + WS_HA8 + (size_t)R * DM; bf16_t* hp = (bf16_t*)(F.ws + WS_HA) + (size_t)R * DM;
#pragma unroll
            for (int j = 0; j < 4; ++j) { const int c = 256 * j + 4 * lane; const f32x4 g = gnv[j], sh = shv[u][j], sc = scv[u][j];
                f32x4 h = (v[u][j] * rstd) * g; h = h * (sc + 1.f) + sh;
                if (G1_F8_PARTS != 0) *(unsigned*)(hp8 + c) = pk4_fp8(h[0], h[1], h[2], h[3]);
                if (G1_F8_PARTS != 0x7f) { u32x2 w; w.x = pk2(h[0], h[1]); w.y = pk2(h[2], h[3]); *(u32x2*)(hp + c) = w; } }
        }
    }
}
__device__ __forceinline__ void final_phase(const Frame& F, KArgs A) {
    const int gw = F.vcu * NWAVES + F.wave, NGW = F.G * NWAVES, lane = F.lane;
    constexpr int NLAT = NB * SEQ;
    for (int T0 = gw; T0 < NLAT; T0 += 2 * NGW) {
        f32x4 v[2][4]; float* xp[2]; int cond[2]; bool ok[2]; YRows y[2]; u32x4 t[2];
#pragma unroll
        for (int u = 0; u < 2; ++u) { const int T = T0 + u * NGW; ok[u] = T < NLAT; const int Tc = ok[u] ? T : T0; const int b = Tc / SEQ; cond[u] = b;
            xp[u] = F.out + (size_t)Tc * DM; const bf16_t* xr = xb_row(F.ws, b * PBR + LC + (Tc - b * SEQ));
#pragma unroll
            for (int j = 0; j < 4; ++j) v[u][j] = bf4(*(const u32x2*)(xr + 256 * j + 4 * lane));
            t[u] = tokc_load(F, b * PBR + LC + (Tc - b * SEQ));
        }
#pragma unroll
        for (int u = 0; u < 2; ++u) { const int T = ok[u] ? T0 + u * NGW : T0; const int b = T / SEQ; y_load(F, t[u], y[u], b * PBR + LC + (T - b * SEQ)); }
#pragma unroll
        for (int u = 0; u < 2; ++u) { if (!ok[u]) continue;
            if (DBG_STOP_AFTER >= N_PHASES - 2) combine_apply(F, y[u], cond[u], NLAYER - 1, v[u]);
            float ss = 0.f;
#pragma unroll
            for (int j = 0; j < 4; ++j) ss += (v[u][j][0] * v[u][j][0] + v[u][j][1] * v[u][j][1]) + (v[u][j][2] * v[u][j][2] + v[u][j][3] * v[u][j][3]);
            const float rstd = 1.f / sqrtf(wave_sum(ss) * (1.f / DM) + EPSN);
#pragma unroll
            for (int j = 0; j < 4; ++j) { const int c = 256 * j + 4 * lane; const f32x4 g = *(const f32x4*)(A->in[I_GFIN] + c); *(f32x4*)(xp[u] + c) = (v[u][j] * rstd) * g; }
        }
    }
}
__device__ __forceinline__ void r1_phase(const Frame& F, KArgs A, int l, int pv = 0) {
    LAS f32x4* wr4 = (LAS f32x4*)F.lds;
    LAS unsigned* cw = (LAS unsigned*)(F.lds + 65536);
    LAS unsigned* bs = (LAS unsigned*)(F.lds + 65536 + 512);
    LAS unsigned* rec = (LAS unsigned*)(F.lds + 65536 + 1024);
    for (int idx = F.tid; idx < DM * NEXP; idx += NWAVES * 64) { const int k = idx >> 4, e = idx & 15, j = k >> 8, ln = (k & 255) >> 2, i = k & 3, q = e >> 2, t = e & 3;
        ((LAS float*)F.lds)[((((j * 4 + i) * 4 + q) * 64 + ln) << 2) + t] = A->in[I_WROUT][idx]; }
    if (F.tid < 128) cw[F.tid] = 0u;
    __syncthreads();
    const int lane = F.lane, wave = F.wave;
    constexpr int RPW = TR / 256 / NWAVES;
    const bool last = (l == NLAYER - 1);
    u32x2 vn[4];
    { const bf16_t* x0 = xb_row(F.ws, F.vcu * (TR / 256) + wave * RPW);
#pragma unroll
        for (int j = 0; j < 4; ++j) vn[j] = *(const u32x2*)(x0 + 256 * j + 4 * lane); }
    for (int i = 0; i < RPW; ++i) {
        const int R = F.vcu * (TR / 256) + wave * RPW + i;
        const int b = R / PBR, p = R - b * PBR;
        if (last && p < LC) { if (lane == 0) rec[(wave * RPW + i) * 4] = 255u;
            if (i + 1 < RPW) { const bf16_t* xn = xb_row(F.ws, R + 1);
#pragma unroll
                for (int j = 0; j < 4; ++j) vn[j] = *(const u32x2*)(xn + 256 * j + 4 * lane); }
            continue; }
        const int cond = cond_of(R);
        f32x4 v[4]; float ss = 0.f;
#pragma unroll
        for (int j = 0; j < 4; ++j) { v[j] = bf4(vn[j]); ss += (v[j][0] * v[j][0] + v[j][1] * v[j][1]) + (v[j][2] * v[j][2] + v[j][3] * v[j][3]); }
        if (i + 1 < RPW) { const bf16_t* xn = xb_row(F.ws, R + 1);
#pragma unroll
            for (int j = 0; j < 4; ++j) vn[j] = *(const u32x2*)(xn + 256 * j + 4 * lane); }
        const float rstd = 1.f / sqrtf(wave_sum(ss) * (1.f / DM) + EPSN);
        const float* gn = A->in[I_GN2] + l * DM; const float* md = (const float*)(F.ws + WS_MODV) + ((size_t)l * NCOND + cond) * MODW + 3 * DM;
        unsigned char* hp = F.ws + WS_HA + (size_t)R * DM;
        float lg[NEXP];
#pragma unroll
        for (int e = 0; e < NEXP; ++e) lg[e] = 0.f;
        f32x4 gv4[4], shv4[4], scv4[4];
#pragma unroll
        for (int j = 0; j < 4; ++j) { const int c = 256 * j + 4 * lane; gv4[j] = *(const f32x4*)(gn + c); shv4[j] = *(const f32x4*)(md + c); scv4[j] = *(const f32x4*)(md + DM + c); }
#pragma unroll
        for (int j = 0; j < 4; ++j) { const int c = 256 * j + 4 * lane; const f32x4 g = gv4[j], sh = shv4[j], sc = scv4[j];
            f32x4 h = (v[j] * rstd) * g; h = h * (sc + 1.f) + sh;
            *(unsigned*)(hp + c) = pk4_fp8(h[0], h[1], h[2], h[3]);
            if (pv != 1)
#pragma unroll
            for (int ii = 0; ii < 4; ++ii)
#pragma unroll
                for (int q = 0; q < 4; ++q) { const f32x4 w4 = R1_GLOBAL_W ? *(const f32x4*)(A->in[I_WROUT] + (size_t)(c + ii) * NEXP + 4 * q) : wr4[((j * 4 + ii) * 4 + q) * 64 + lane];
                    lg[4 * q + 0] += h[ii] * w4[0]; lg[4 * q + 1] += h[ii] * w4[1]; lg[4 * q + 2] += h[ii] * w4[2]; lg[4 * q + 3] += h[ii] * w4[3]; } }
#pragma unroll
        for (int e = 0; e < NEXP; ++e) lg[e] = (pv == 2 ? lg[e] : wave_sum(lg[e])) + A->in[I_BROUT][e];
        int best = 0; float bv = lg[0];
#pragma unroll
        for (int e = 1; e < NEXP; ++e) if (lg[e] > bv) { bv = lg[e]; best = e; }
        const int grp = best >> 2; int e2 = -1; float v2 = 0.f;
#pragma unroll
        for (int e = 0; e < NEXP; ++e) if ((e >> 2) == grp && e != best && (e2 < 0 || lg[e] > v2)) { v2 = lg[e]; e2 = e; }
        const float g1 = __builtin_amdgcn_rcpf(1.f + __builtin_amdgcn_exp2f(-1.4426950408889634f * fabsf(bv - v2)));
        const unsigned r1 = cw[wave * 16 + best], r2 = cw[wave * 16 + e2];
        LDS_WAIT(); asm volatile("" ::: "memory");
        if (lane == 0) { cw[wave * 16 + best] = r1 + 1u; cw[wave * 16 + e2] = r2 + 1u;
            LAS unsigned* rr = rec + (wave * RPW + i) * 4; rr[0] = (unsigned)best | ((unsigned)e2 << 8); rr[1] = r1; rr[2] = r2; rr[3] = 0u;
            ((float*)(F.ws + WS_TOKGATE))[R] = g1; }
        LDS_WAIT(); asm volatile("" ::: "memory");
    }
    __syncthreads();
    if (F.tid < NEXP) { unsigned run = 0u; for (int w = 0; w < NWAVES; ++w) { bs[w * 16 + F.tid] = run; run += cw[w * 16 + F.tid]; }
        ((unsigned*)(F.ws + WS_CNT))[F.vcu * 16 + F.tid] = run; }
    __syncthreads();
    if (lane < RPW) { const LAS unsigned* rr = rec + (wave * RPW + lane) * 4; const int R = F.vcu * (TR / 256) + wave * RPW + lane;
        u32x4 o; o.x = rr[0];
        if ((o.x & 255u) == 255u) { o.y = 0u; o.z = 0u; o.w = 0u; }
        else { o.y = rr[1] + bs[wave * 16 + (o.x & 255u)]; o.z = rr[2] + bs[wave * 16 + ((o.x >> 8) & 255u)]; o.w = rr[3]; }
        ((u32x4*)(F.ws + WS_TOKINFO))[R] = o; }
    __syncthreads();
}
__device__ __forceinline__ void r2_phase(const Frame& F, KArgs A, int l) {
    LAS unsigned* cn = (LAS unsigned*)F.lds;
    LAS unsigned* pst = (LAS unsigned*)(F.lds + 16384);
    LAS int* tab = (LAS int*)(F.lds + 16384 + 256);
    for (int i = F.tid; i < 256 * 16; i += NWAVES * 64) cn[i] = ((const unsigned*)(F.ws + WS_CNT))[i];
    __syncthreads();
    if (F.tid < NEXP) { unsigned tot = 0u, pre = 0u; for (int w = 0; w < 256; ++w) { const unsigned c = cn[w * 16 + F.tid]; if (w < F.vcu) pre += c; tot += c; }
        pst[32 + F.tid] = tot; pst[16 + F.tid] = pre; }
    __syncthreads();
    if (F.tid == 0) { unsigned run = 0u; for (int e = 0; e < NEXP; ++e) { const unsigned pad = (pst[32 + e] + 255u) & ~255u; pst[e] = run + pst[16 + e];
            for (unsigned bk = run >> 8; bk < ((run + pad) >> 8); ++bk) tab[bk] = e; run += pad; }
        tab[300] = (int)(run >> 8); }
    __syncthreads();
    if (F.vcu == 0) { for (int i = F.tid; i < 320; i += NWAVES * 64) ((int*)(F.ws + WS_BLKTAB))[i] = (i < MAXBLK || i == 300) ? tab[i] : 0; }
    const int lane = F.lane, wave = F.wave;
    constexpr int RPW = TR / 256 / NWAVES;
    const int R0 = F.vcu * (TR / 256) + wave * RPW;
    unsigned s1 = 0u, s2 = 0u, on = 0u;
    if (lane < RPW) { const int R = R0 + lane; const unsigned* ip = (const unsigned*)((const u32x4*)(F.ws + WS_TOKINFO) + R);
        const unsigned ix = ld_dev(ip), iy = ld_dev(ip + 1), iz = ld_dev(ip + 2); const unsigned gt = ld_dev((const float*)(F.ws + WS_TOKGATE) + R);
        on = ((ix & 255u) != 255u) ? 1u : 0u;
        if (on) { s1 = pst[ix & 255u] + iy; s2 = pst[(ix >> 8) & 255u] + iz; }
        u32x4 tc; tc.x = s1; tc.y = s2; tc.z = on ? gt : 0u; tc.w = on; ((u32x4*)(F.ws + WS_TOKC))[R] = tc; }
#pragma unroll
    for (int i0 = 0; i0 < RPW; i0 += 6) {
        u32x4 a[6];
#pragma unroll
        for (int k = 0; k < 6; ++k) if (i0 + k < RPW) a[k] = ((const u32x4*)(F.ws + WS_HA + (size_t)(R0 + i0 + k) * DM))[lane];
#pragma unroll
        for (int k = 0; k < 6; ++k) if (i0 + k < RPW) {
            const unsigned o1 = __builtin_amdgcn_readlane(s1, i0 + k), o2 = __builtin_amdgcn_readlane(s2, i0 + k), v = __builtin_amdgcn_readlane(on, i0 + k);
            if (v) { ((u32x4*)(F.ws + WS_XB + (size_t)o1 * DM))[lane] = a[k]; ((u32x4*)(F.ws + WS_XB + (size_t)o2 * DM))[lane] = a[k]; } }
    }
}
__device__ __forceinline__ void expert_conv_unit(const Frame& F, KArgs A, int l, int cu) {
    int td = F.tid; asm volatile("" : "+v"(td));
    constexpr int TW_M = (DM / 64) * (DM / 256);
#define EC_GEOM(j) const int it = cu * 6 + (j); const int mat = it / TW_M, t = it % TW_M, e = mat / 3, which = mat % 3, kb = t / 4, nb = t % 4, n0 = 256 * nb; \
        const float* W = A->in[which == 0 ? I_WE1 : (which == 1 ? I_WE3 : I_WE2)] + ((size_t)l * NEXP + e) * DM * DM
    TrW tw[2];
    { EC_GEOM(0); trw_load(tw[0], W, DM, 64 * kb, n0, td); }
#pragma unroll
    for (int j = 0; j < 6; ++j) {
        if (j + 1 < 6) { EC_GEOM(j + 1); trw_load(tw[(j + 1) & 1], W, DM, 64 * kb, n0, td); }
        EC_GEOM(j);
        unsigned char* const ws = F.ws;
        auto row = [=](int n) -> unsigned char* { const int ng = n0 + n;
            return which == 2 ? ws + WS_W2 + ((size_t)e * DM + ng) * DM : ws + WS_W13 + ((size_t)e * 2048 + (size_t)(ng >> 7) * 256 + which * 128 + (ng & 127)) * DM; };
        trw_store<true>(tw[j & 1], 64 * kb, row, F.lds, td);
    }
#undef EC_GEOM
}

namespace att {
constexpr float SCALE = 0.125f;
constexpr float TOP = 5.f, SLACK = 3.5f;
constexpr int SHM_V = 64 * 128 * 2, SHM_K = 64 * 128 * 2;
typedef int i32x4 __attribute__((ext_vector_type(4)));
typedef int i32x8 __attribute__((ext_vector_type(8)));
#define KSWZ(row, colB) ((row) * 256 + ((colB) ^ (((row) & 7) << 4)))
__device__ __forceinline__ int crow(int r, int hi) { return (r & 3) + 8 * (r >> 2) + 4 * hi; }
__device__ __forceinline__ void partialSM(f32x16& p0, f32x16& p1, float& m_reg, f32x16& mneg, float& alpha, bool first, int dryv = 0) {
  alpha = 1.f;
  float pmax = p0[0]; if (dryv != 5 && dryv != 9) { for (int r = 1; r < 16; ++r) pmax = fmaxf(pmax, p0[r]); for (int r = 0; r < 16; ++r) pmax = fmaxf(pmax, p1[r]); }
  { auto rr = __builtin_amdgcn_permlane32_swap(__float_as_uint(pmax), __float_as_uint(pmax), false, false);
    pmax = fmaxf(__uint_as_float(rr[0]), __uint_as_float(rr[1])); }
  if (first || !__builtin_expect(__all(pmax <= TOP + SLACK), 1)) { const float d = first ? pmax - TOP : fmaxf(pmax - TOP, 0.f); alpha = __builtin_amdgcn_exp2f(-d); m_reg += d;
    for (int r = 0; r < 16; ++r) p0[r] -= d; for (int r = 0; r < 16; ++r) p1[r] -= d; { const float nm = -m_reg; asm volatile("v_mov_b32 %0, %16\n\tv_mov_b32 %1, %16\n\tv_mov_b32 %2, %16\n\tv_mov_b32 %3, %16\n\tv_mov_b32 %4, %16\n\tv_mov_b32 %5, %16\n\tv_mov_b32 %6, %16\n\tv_mov_b32 %7, %16\n\tv_mov_b32 %8, %16\n\tv_mov_b32 %9, %16\n\tv_mov_b32 %10, %16\n\tv_mov_b32 %11, %16\n\tv_mov_b32 %12, %16\n\tv_mov_b32 %13, %16\n\tv_mov_b32 %14, %16\n\tv_mov_b32 %15, %16"
        : "+v"(mneg[0]), "+v"(mneg[1]), "+v"(mneg[2]), "+v"(mneg[3]), "+v"(mneg[4]), "+v"(mneg[5]), "+v"(mneg[6]), "+v"(mneg[7]), "+v"(mneg[8]), "+v"(mneg[9]), "+v"(mneg[10]), "+v"(mneg[11]), "+v"(mneg[12]), "+v"(mneg[13]), "+v"(mneg[14]), "+v"(mneg[15]) : "v"(nm)); } }
  if (dryv != 2 && dryv != 9) for (int r = 0; r < 16; ++r) p0[r] = __builtin_amdgcn_exp2f(p0[r]);
}
__device__ __forceinline__ void finishSM(f32x16& p0, f32x16& p1, i32x8& pa, int dryv = 0) {
  if (dryv != 2 && dryv != 9) for (int r = 0; r < 16; ++r) p1[r] = __builtin_amdgcn_exp2f(p1[r]);
#pragma unroll
  for (int t = 0; t < 8; ++t) { int w; asm volatile("" : "=v"(w)); w = __builtin_amdgcn_cvt_pk_fp8_f32(p0[t], p0[t + 8], w, false); pa[t] = __builtin_amdgcn_cvt_pk_fp8_f32(p1[t], p1[t + 8], w, true); }
}
#define KSWZ8(row, colB) ((row) * 128 + ((colB) ^ ((((row) >> 1) & 7) << 4)))
__device__ __forceinline__ void qkt(f32x16& p0, f32x16& p1, const char* Ks, const i32x8 qr, int r32, int hi, int csub, const f32x16& mneg) {
  const int cb = csub * 64 + hi * 32;
  const i32x4 a0 = *reinterpret_cast<const i32x4*>(Ks + KSWZ8(r32, cb)), a1 = *reinterpret_cast<const i32x4*>(Ks + KSWZ8(r32, cb + 16));
  const i32x4 b0 = *reinterpret_cast<const i32x4*>(Ks + KSWZ8(32 + r32, cb)), b1 = *reinterpret_cast<const i32x4*>(Ks + KSWZ8(32 + r32, cb + 16));
  p0 = __builtin_amdgcn_mfma_scale_f32_32x32x64_f8f6f4(__builtin_shufflevector(a0, a1, 0, 1, 2, 3, 4, 5, 6, 7), qr, mneg, 0, 0, 0, 0, 0, 0);
  p1 = __builtin_amdgcn_mfma_scale_f32_32x32x64_f8f6f4(__builtin_shufflevector(b0, b1, 0, 1, 2, 3, 4, 5, 6, 7), qr, mneg, 0, 0, 0, 0, 0, 0);
}
struct VRegs { i32x4 lo[4], hh[4]; };
template <int H> __device__ __forceinline__ void pv_load(VRegs& v, const char* Vs, int voff) {
#pragma unroll
  for (int d0 = 2 * H; d0 < 2 * H + 2; ++d0) { v.lo[d0] = *reinterpret_cast<const i32x4*>(Vs + d0 * 2048 + voff); v.hh[d0] = *reinterpret_cast<const i32x4*>(Vs + d0 * 2048 + (voff ^ 16)); }
}
__device__ __forceinline__ void pv_mma(f32x16* o, f32x16& lacc, const i32x8 ones, const VRegs& v, i32x8 pa) {
#pragma unroll
  for (int d0 = 0; d0 < 4; ++d0) { const i32x8 vv = __builtin_shufflevector(v.lo[d0], v.hh[d0], 0, 1, 2, 3, 4, 5, 6, 7);
    o[d0] = __builtin_amdgcn_mfma_scale_f32_32x32x64_f8f6f4(pa, vv, o[d0], 0, 0, 0, 0, 0, 0); }
  lacc = __builtin_amdgcn_mfma_scale_f32_32x32x64_f8f6f4(pa, ones, lacc, 0, 0, 0, 0, 0, 0);
}
__device__ __forceinline__ void attn_unit(const unsigned char* __restrict__ Qb, const unsigned char* __restrict__ Kh, const unsigned char* __restrict__ VTh, unsigned char* Ob,
                                          int seq, float lam, float oscale, const float* __restrict__ gsub, char* lds, LAS unsigned char* ldsl, int tid, bool dry = false) {
  asm volatile("" : "+v"(tid));
  const int wid = __builtin_amdgcn_readfirstlane(tid >> 6), lane = tid & 63, r32 = lane & 31, hi = lane >> 5, csub = wid >> 2, wq = wid & 3;
  constexpr int STG = 16384, VOFF = 8192;
  float* ws = (float*)(lds + 4 * STG) + wid * 64; float* al_l = ws + 32;
  float m_reg = 0.f; f32x16 o[4] = {}, lacc = {}, mneg = {}; i32x8 qr, ones; { int o1 = 0x38383838; asm volatile("" : "+v"(o1)); ones = (i32x8){o1, o1, o1, o1, o1, o1, o1, o1}; }
  { const unsigned char* Qw = Qb + (size_t)(wq * 32 + r32) * DM + csub * 64 + hi * 32;
    const i32x4 q0 = *reinterpret_cast<const i32x4*>(Qw), q1 = *reinterpret_cast<const i32x4*>(Qw + 16); qr = __builtin_shufflevector(q0, q1, 0, 1, 2, 3, 4, 5, 6, 7); }
  const unsigned kofs = (unsigned)((tid >> 3) * DM + (((tid & 7) ^ ((tid >> 4) & 7)) << 4));
  const unsigned vofs = (unsigned)((tid >> 2) * (68 * 64) + (((tid & 3) ^ ((tid >> 4) & 3)) << 4));
  LAS unsigned char* dmaw = ldsl + wid * 1024;
  const int voff = r32 * 64 + (((2 * hi) ^ ((r32 >> 2) & 3)) << 4);
#define DMA(t, S) do { if (!(dry && ATT_VAR == 1)) { LAS unsigned char* d_ = dmaw + (S) * STG; \
    const unsigned ko_ = kofs + (unsigned)(t) * (unsigned)(64 * DM), vo_ = vofs + (unsigned)(t) * 64u;     \
    __builtin_amdgcn_global_load_lds((const unsigned*)(Kh + ko_), (LAS unsigned*)d_, 16, 0, 0); \
    __builtin_amdgcn_global_load_lds((const unsigned*)(VTh + vo_), (LAS unsigned*)(d_ + VOFF), 16, 0, 0); } } while (0)
#define KST(S) (lds + (S) * STG)
#define VST(S) (lds + (S) * STG + VOFF)
#define RESC(a) do { if (__any((a) < 1.f)) { if (hi == 0) al_l[r32] = (a); asm volatile("s_waitcnt lgkmcnt(0)" ::: "memory"); \
    for (int r = 0; r < 16; ++r) { const float a_ = al_l[crow(r, hi)]; lacc[r] *= a_; for (int d = 0; d < 4; ++d) o[d][r] *= a_; } } } while (0)
#define BARRIER() do { if (!(dry && ATT_VAR == 6)) asm volatile("s_barrier" ::: "memory"); } while (0)
  f32x16 pA0, pA1, pB0, pB1; float alA, alB; i32x8 pa; const int NT = seq / 64; VRegs vr;
  DMA(0, 0); DMA(1, 1);
  asm volatile("s_waitcnt vmcnt(2)" ::: "memory"); __syncthreads();
  DMA(2, 2);
  qkt(pA0, pA1, KST(0), qr, r32, hi, csub, mneg); partialSM(pA0, pA1, m_reg, mneg, alA, true);
#define STEP(u, SK, SV, SD, PN0, PN1, ALN, PC0, PC1, VMC, DMACOND) do { \
    asm volatile("s_waitcnt vmcnt(" #VMC ")" ::: "memory"); BARRIER(); if (DMACOND) DMA((u) + 2, SD); \
    SBAR(); pv_load<0>(vr, VST(SV), voff); if (!(dry && (ATT_VAR == 4 || ATT_VAR == 8))) qkt(PN0, PN1, KST(SK), qr, r32, hi, csub, mneg); SBAR(); pv_load<1>(vr, VST(SV), voff); \
    finishSM(PC0, PC1, pa, dry ? ATT_VAR : 0); SBAR(); \
    if (!(dry && (ATT_VAR == 3 || ATT_VAR == 8))) pv_mma(o, lacc, ones, vr, pa); partialSM(PN0, PN1, m_reg, mneg, ALN, false, dry ? ATT_VAR : 0); \
    RESC(ALN); } while (0)
  int u = 1;
  for (; u + 3 < NT; u += 4) {
    STEP(u,     1, 0, 3, pB0, pB1, alB, pA0, pA1, 2, true);
    STEP(u + 1, 2, 1, 0, pA0, pA1, alA, pB0, pB1, 2, true);
    STEP(u + 2, 3, 2, 1, pB0, pB1, alB, pA0, pA1, 2, true);
    STEP(u + 3, 0, 3, 2, pA0, pA1, alA, pB0, pB1, 2, true);
  }
  STEP(u,     1, 0, 3, pB0, pB1, alB, pA0, pA1, 2, true);
  STEP(u + 1, 2, 1, 0, pA0, pA1, alA, pB0, pB1, 2, false);
  STEP(u + 2, 3, 2, 1, pB0, pB1, alB, pA0, pA1, 0, false);
  pv_load<0>(vr, VST(3), voff); pv_load<1>(vr, VST(3), voff); finishSM(pB0, pB1, pa); SBAR();
  pv_mma(o, lacc, ones, vr, pa);
  float rli[16];
#pragma unroll
  for (int r = 0; r < 16; ++r) rli[r] = __builtin_amdgcn_rcpf(lacc[r]);
  __syncthreads();
  float* Cs = (float*)lds;
  if (csub == 1) {
#pragma unroll
    for (int r = 0; r < 16; ++r) { const float f = rli[r] * lam; float* cp = Cs + (wq * 32 + crow(r, hi)) * 128 + r32;
#pragma unroll
      for (int d0 = 0; d0 < 4; ++d0) cp[d0 * 32] = o[d0][r] * f; }
  }
  __syncthreads();
  if (csub == 0) {
    float gs[4];
#pragma unroll
    for (int d0 = 0; d0 < 4; ++d0) gs[d0] = gsub[d0 * 32 + r32] * oscale;
#pragma unroll
    for (int r = 0; r < 16; ++r) { const int row = wq * 32 + crow(r, hi); const float* cp = Cs + row * 128 + r32; float v[4]; float ss = 0.f;
#pragma unroll
      for (int d0 = 0; d0 < 4; ++d0) { v[d0] = o[d0][r] * rli[r] - cp[d0 * 32]; ss += v[d0] * v[d0]; }
      ss = dpp_add<0xB1, 0xF>(ss); ss = dpp_add<0x4E, 0xF>(ss); ss = dpp_add<0x141, 0xF>(ss); ss = dpp_add<0x140, 0xF>(ss);
      { auto rr = __builtin_amdgcn_permlane16_swap(__float_as_uint(ss), __float_as_uint(ss), false, false); ss = __uint_as_float(rr[0]) + __uint_as_float(rr[1]); }
      const float rstd = 1.f / sqrtf(ss * (1.f / 128.f) + EPSN);
      unsigned char* op = Ob + (size_t)row * DM + r32;
#pragma unroll
      for (int d0 = 0; d0 < 4; ++d0) { const float x = v[d0] * rstd * gs[d0]; const unsigned ov = (unsigned)__builtin_amdgcn_cvt_pk_fp8_f32(x, x, 0, false); if (!dry) op[d0 * 32] = (unsigned char)ov; else asm volatile("" :: "v"(ov)); } }
  }
  __syncthreads();
#undef DMA
#undef KST
#undef VST
#undef STEP
#undef BARRIER
#undef RESC
}
}

__device__ __forceinline__ void scan_unit(const Frame& F, KArgs A, int l, int b, int blk, bool dry = false) {
    int tid = F.tid; asm volatile("" : "+v"(tid));
    const int lane = tid & 63, w = F.wave, fr = lane & 15, q4 = lane >> 4, tr = tid >> 4, cg = tid & 15;
    LAS unsigned char* Us = F.lds;
    LAS float* Hs = (LAS float*)(F.lds + 16384);
    const size_t rowb = (size_t)b * PBR;
    const size_t coff = rowb * DM + (size_t)blk * 128 + cg * 8;
    const bf16_t* rxp = (const bf16_t*)(F.ws + WS_PARTS) + coff;
    bf16_t* rgp = (bf16_t*)(F.ws + WS_PARTS) + 4 * PART_ELEMS + coff;
    bf16_t* hfp = (bf16_t*)(F.ws + WS_HA) + coff;
    float zs_ = 0.f; asm volatile("" : "+v"(zs_));
    float cwv[4][8], cbv[8];
#pragma unroll
    for (int i = 0; i < 8; ++i) { cbv[i] = A->in[I_CONVB][l * DM + blk * 128 + cg * 8 + i];
#pragma unroll
        for (int j = 0; j < 4; ++j) cwv[j][i] = A->in[I_CONVW][(l * 4 + j) * DM + blk * 128 + cg * 8 + i]; }
    for (int dir = 0; dir < 2; ++dir) {
        const bf16_t* Wt = (const bf16_t*)(F.ws + WS_WMIX + (size_t)l * WMIX_LAYER + WM_LRU) + (size_t)(dir * 8 + blk) * 256 * 128;
        bf16x8 bfa[4], bfx[4];
#pragma unroll
        for (int kk = 0; kk < 4; ++kk) { bfa[kk] = *(const bf16x8*)(Wt + (size_t)(16 * w + fr) * 128 + kk * 32 + q4 * 8); bfx[kk] = *(const bf16x8*)(Wt + (size_t)(128 + 16 * w + fr) * 128 + kk * 32 + q4 * 8); }
        const int pidx = (l * 2 + dir) * DM + blk * 128 + 16 * w + fr;
        const float ba = A->in[I_LBA][pidx], bx = A->in[I_LBX][pidx], lamv = A->in[I_LLAM][pidx];
        const float cl2 = -8.f * log1pf(expf(-lamv)) * 1.4426950408889634f;
        float h = 0.f;
        u32x4 rxq[2][4], hfq[2], rgq[2];
#define STEP_GEOM(n, T0, LSEG, SEGB) do { const bool sc_ = (n) < 4; const int ci_ = sc_ ? (n) : (n) - 4, nch_ = sc_ ? 4 : 64; T0 = 64 * (dir ? nch_ - 1 - ci_ : ci_); LSEG = sc_ ? LC : SEQ; SEGB = sc_ ? 0 : LC; } while (0)
#define LOAD_RX(n) do { int t0_, ls_, sb_; STEP_GEOM(n, t0_, ls_, sb_); \
        _Pragma("unroll") for (int tk = 0; tk < 2; ++tk) _Pragma("unroll") for (int j = 0; j < 4; ++j) { const int trow = t0_ + tr + 32 * tk + j - 2; \
            const int tc_ = (trow >= 0 && trow < ls_) ? trow : t0_ + tr + 32 * tk;     \
            rxq[tk][j] = *(const u32x4*)(rxp + (size_t)(sb_ + tc_) * DM); } } while (0)
#define LOAD_HG(n) do { int t0_, ls_, sb_; STEP_GEOM(n, t0_, ls_, sb_); \
        _Pragma("unroll") for (int tk = 0; tk < 2; ++tk) { const size_t ro = (size_t)(sb_ + t0_ + tr + 32 * tk) * DM; \
            hfq[tk] = __builtin_nontemporal_load((const u32x4*)(hfp + ro)); rgq[tk] = *(const u32x4*)(rgp + ro); } } while (0)
        LOAD_RX(0); if (dir) LOAD_HG(0);
        for (int n = 0; n < 68; ++n) {
            int t0, lseg, segb; STEP_GEOM(n, t0, lseg, segb);
#pragma unroll
            for (int tk = 0; tk < 2; ++tk) {
                float u[8];
#pragma unroll
                for (int i = 0; i < 8; ++i) u[i] = cbv[i];
#pragma unroll
                for (int j = 0; j < 4; ++j) { u32x4 x = rxq[tk][j];
                    { const int trow = t0 + tr + 32 * tk + j - 2; const unsigned mk = (trow >= 0 && trow < lseg) ? 0xffffffffu : 0u; x.x &= mk; x.y &= mk; x.z &= mk; x.w &= mk; }
                    u[0] += bflo(x.x) * cwv[j][0]; u[1] += bfhi(x.x) * cwv[j][1]; u[2] += bflo(x.y) * cwv[j][2]; u[3] += bfhi(x.y) * cwv[j][3];
                    u[4] += bflo(x.z) * cwv[j][4]; u[5] += bfhi(x.z) * cwv[j][5]; u[6] += bflo(x.w) * cwv[j][6]; u[7] += bfhi(x.w) * cwv[j][7]; }
                const int tl = tr + 32 * tk, tau = dir ? 63 - tl : tl;
                u32x4 wv; wv.x = pk2(u[0], u[1]); wv.y = pk2(u[2], u[3]); wv.z = pk2(u[4], u[5]); wv.w = pk2(u[6], u[7]);
                *(LAS u32x4*)(Us + KSWZ(tau, cg * 16)) = wv;
            }
            if (n + 1 < 68) LOAD_RX(n + 1);
            __syncthreads();
            f32x4 Ga[4], Gx[4];
#pragma unroll
            for (int tt = 0; tt < 4; ++tt) { Ga[tt] = (f32x4){zs_, zs_, zs_, zs_}; Gx[tt] = (f32x4){zs_, zs_, zs_, zs_};
#pragma unroll
                for (int kk = 0; kk < 4; ++kk) { const bf16x8 af = *(const LAS bf16x8*)(Us + KSWZ(16 * tt + fr, 64 * kk + 16 * q4));
                    Ga[tt] = __builtin_amdgcn_mfma_f32_16x16x32_bf16(af, bfa[kk], Ga[tt], 0, 0, 0);
                    Gx[tt] = __builtin_amdgcn_mfma_f32_16x16x32_bf16(af, bfx[kk], Gx[tt], 0, 0, 0); } }
#pragma unroll
            for (int tt = 0; tt < 4; ++tt) {
                float Al[4], Bl[4]; float Ac = 1.f, Bc = 0.f;
#pragma unroll
                for (int rg_ = 0; rg_ < 4; ++rg_) { const int tau = 16 * tt + 4 * q4 + rg_;
                    const float uu = __builtin_bit_cast(float, (unsigned)(*(const LAS unsigned short*)(Us + KSWZ(tau, (16 * w + fr) * 2))) << 16);
                    const float r = fast_sigmoid(Ga[tt][rg_] + ba), av = __builtin_amdgcn_exp2f(cl2 * r), ig = fast_sigmoid(Gx[tt][rg_] + bx);
                    const float bv = __builtin_amdgcn_sqrtf(fmaxf(1.f - av * av, 0.f)) * ig * uu;
                    Bc = av * Bc + bv; Ac = av * Ac; Al[rg_] = Ac; Bl[rg_] = Bc; }
                { const float A1 = __shfl_up(Ac, 16), B1 = __shfl_up(Bc, 16); if (q4 >= 1) { Bc = Ac * B1 + Bc; Ac = Ac * A1; } }
                { const float A2 = __shfl_up(Ac, 32), B2 = __shfl_up(Bc, 32); if (q4 >= 2) { Bc = Ac * B2 + Bc; Ac = Ac * A2; } }
                float Ae = __shfl_up(Ac, 16), Be = __shfl_up(Bc, 16); if (q4 == 0) { Ae = 1.f; Be = 0.f; }
                const float hin = Ae * h + Be;
                const float At = __shfl(Ac, 48 + fr), Bt = __shfl(Bc, 48 + fr);
#pragma unroll
                for (int rg_ = 0; rg_ < 4; ++rg_) Hs[(16 * tt + 4 * q4 + rg_) * 132 + 16 * w + fr] = Al[rg_] * hin + Bl[rg_];
                h = At * h + Bt;
            }
            __syncthreads();
#pragma unroll
            for (int tk = 0; tk < 2; ++tk) { const int tl = tr + 32 * tk, tau = dir ? 63 - tl : tl; const size_t ro = (size_t)(segb + t0 + tl) * DM;
                const f32x4 h0 = *(const LAS f32x4*)(Hs + tau * 132 + cg * 8), h1 = *(const LAS f32x4*)(Hs + tau * 132 + cg * 8 + 4);
                u32x4 o;
                if (dir == 0) { o.x = pk2(h0[0], h0[1]); o.y = pk2(h0[2], h0[3]); o.z = pk2(h1[0], h1[1]); o.w = pk2(h1[2], h1[3]); *(u32x4*)(hfp + ro) = o; }
                else { const u32x4 f = hfq[tk], g = rgq[tk];
                    o.x = pk2((h0[0] + bflo(f.x)) * bflo(g.x), (h0[1] + bfhi(f.x)) * bfhi(g.x)); o.y = pk2((h0[2] + bflo(f.y)) * bflo(g.y), (h0[3] + bfhi(f.y)) * bfhi(g.y));
                    o.z = pk2((h1[0] + bflo(f.z)) * bflo(g.z), (h1[1] + bfhi(f.z)) * bfhi(g.z)); o.w = pk2((h1[2] + bflo(f.w)) * bflo(g.w), (h1[3] + bfhi(f.w)) * bfhi(g.w));
                    if (!dry) *(u32x4*)(rgp + ro) = o; }
            }
            if (dir && n + 1 < 68) LOAD_HG(n + 1);
        }
        VM_WAIT(); __syncthreads();
#undef STEP_GEOM
#undef LOAD_RX
#undef LOAD_HG
    }
}

#ifndef PH_MASK
#define PH_MASK 0xFFF
#endif
#define PH_ON(k) (((PH_MASK) >> (k)) & 1)
#ifndef LAYER_UNROLL
#define LAYER_UNROLL 1
#endif
#ifndef G1_PLAIN_PROBE
#define G1_PLAIN_PROBE 0
#endif
#ifndef R1_VAR
#define R1_VAR 0
#endif
#ifndef A1_DRY
#define A1_DRY 0
#endif
#ifndef P0_SKIP_PROBE
#define P0_SKIP_PROBE 0
#endif
#ifndef E2_NOSTORE_PROBE
#define E2_NOSTORE_PROBE 0
#endif
#ifndef REP_MASK
#define REP_MASK 0
#endif
#define REPS(k) ((((REP_MASK) >> (k)) & 1) ? 2 : 1)
#define REPBAR(k, r) do { if ((r) + 1 < REPS(k)) { KArgs Ab = kargs(); XcdBarrier bar; bar.bar = (unsigned*)(Ab->ws + WS_CTL) + CW_BAR; bar.x = xb_xcc_id(); bar.st = (volatile LAS unsigned*)((LAS unsigned char*)lds + MISC_OFF) + 8; xcd_barrier(bar); } } while (0)
__device__ __forceinline__ Frame make_frame(KArgs A, unsigned char* ldsg, int wave0) {
    Frame F;
    F.lds = (LAS unsigned char*)ldsg; F.ldsg = ldsg;
    F.MISC = (volatile LAS unsigned*)(F.lds + MISC_OFF);
    { unsigned m_ = ~0u; asm volatile("" : "+s"(m_));
      F.tid = wave0 * 64 + (int)__builtin_amdgcn_mbcnt_hi(m_, __builtin_amdgcn_mbcnt_lo(m_, 0u)); asm volatile("" : "+v"(F.tid)); } F.lane = F.tid & 63; F.wave = __builtin_amdgcn_readfirstlane(F.tid >> 6);
    F.G = gridDim.x; { const int bx = blockIdx.x; F.vcu = (F.G % 8 == 0) ? (bx % 8) * (F.G / 8) + bx / 8 : bx; }
    F.ws = A->ws; F.ctl = (unsigned*)(F.ws + WS_CTL); F.out = A->out;
    return F;
}
#ifndef DBG_STOP_AFTER
#define DBG_STOP_AFTER 1000
#endif
#define IN(k) (lo <= (k) && (k) < hi && ((k) <= DBG_STOP_AFTER || (k) == N_PHASES - 1))
#define MKF() asm volatile("; PHASE_MARK" ::: "memory"); KArgs A = kargs(); const Frame F = make_frame(A, lds, wave0)
#define SEAM(k) do { if (IN(k) && IN((k) + 1)) { KArgs Ab = kargs(); XcdBarrier bar; bar.bar = (unsigned*)(Ab->ws + WS_CTL) + CW_BAR; bar.x = xb_xcc_id(); \
        bar.st = (volatile LAS unsigned*)((LAS unsigned char*)lds + MISC_OFF) + 8; xcd_barrier(bar); } } while (0)

template <int l> __device__ __forceinline__ void layer_body(unsigned char* lds, const int lo, const int hi, const int wave0) {
        constexpr int pb = 1 + 9 * l;
        for (int rep_ = 0; rep_ < (l == 0 ? REPS(1) : 1); ++rep_) { if (PH_ON(1) && IN(pb + 0)) { MKF(); n1_phase(F, A, l); } if (l == 0) REPBAR(1, rep_); } SEAM(pb + 0);
        for (int rep_ = 0; rep_ < REPS(2); ++rep_) { if (PH_ON(2) && IN(pb + 1)) { MKF();
            unsigned char* wl = F.ws + WS_WMIX + (size_t)l * WMIX_LAYER;
            constexpr unsigned M8 = G1_F8_PARTS & 0x7f, M16 = ~G1_F8_PARTS & 0x7f; constexpr int NP8 = g1_np(M8), NP16 = g1_np(M16);
            const int plain = (REPS(2) == 2 && rep_ == 0 && G1_PLAIN_PROBE) ? 1 : 0;
            if (NP8) {
                pg8::Gemm g{(const bf16_t*)(F.ws + WS_HA8), (const bf16_t*)(wl + WM_WIN), DM / 2}; OrderG1 S{F.G, (int)blockIdx.x, NP8, g1_plist(M8), true};
                EpiG1 E{(bf16_t*)(F.ws + WS_PARTS), (const float*)(F.ws + WS_COS), (const float*)(F.ws + WS_SIN), F.ws + WS_GATES, plain, 1.f / 32.f};
                pg8::gemm_phase<EpiG1, OrderG1, true, true, true>(F.lds, g, S, E, F.tid);
            }
            if (NP8 && NP16) __syncthreads();
            if (NP16) {
                const int G = F.G, rem8 = (NTILE * 4 * NP8) % G & ~7, c2 = ((int)blockIdx.x - rem8 + G) % G;
                pg8::Gemm g{(const bf16_t*)(F.ws + WS_HA), (const bf16_t*)(wl + WM_WIN), DM}; OrderG1 S{F.G, (F.G % 8 == 0) ? c2 : (int)blockIdx.x, NP16, g1_plist(M16), false};
                EpiG1 E{(bf16_t*)(F.ws + WS_PARTS), (const float*)(F.ws + WS_COS), (const float*)(F.ws + WS_SIN), F.ws + WS_GATES, plain, 1.f};
                pg8::gemm_phase<EpiG1, OrderG1, true, true, false>(F.lds, g, S, E, F.tid);
            }
        } REPBAR(2, rep_); } SEAM(pb + 1);
        if ((PH_ON(3) || PH_ON(4)) && IN(pb + 2)) { MKF();
            bf16_t* const parts = (bf16_t*)(F.ws + WS_PARTS);
            const int total = 64 + 2048 + 512 + (l == 0 ? NB * 8 * 2 : 0);
            const float lam = __builtin_bit_cast(float, __builtin_amdgcn_readfirstlane(ld_dev((const float*)(F.ws + WS_LAM) + l * 2))), oscale = __builtin_bit_cast(float, __builtin_amdgcn_readfirstlane(ld_dev((const float*)(F.ws + WS_LAM) + l * 2 + 1)));
            for (int pass = (A1_DRY ? 0 : 1); pass < 2; ++pass) {
            const bool dry = (pass == 0);
            for (;;) {
                if (F.tid == 0) F.MISC[12] = __hip_atomic_fetch_add(F.ctl + CW_QUEUE + 64 * (l + (dry ? 2 : 0)), 1u, __ATOMIC_RELAXED, __HIP_MEMORY_SCOPE_AGENT);
                __syncthreads();
                const int id = __builtin_amdgcn_readfirstlane((int)F.MISC[12]);
                __syncthreads();
                if (id >= total) break;
                if (id < 64) { if (PH_ON(3) && (!dry || (A1_DRY & 1))) scan_unit(F, A, l, id >> 3, id & 7, dry); continue; }
                if (!PH_ON(4) || (dry && !(A1_DRY & 2))) continue;
                int a = id - 64, b, h, r0, seq;
                if (a < 2048) { const int qb = a & 31; h = (a >> 5) & 7; b = a >> 8; r0 = b * PBR + LC + qb * 128; seq = PBR; }
                else if (a < 2048 + 512) { if (!dry) expert_conv_unit(F, A, l, a - 2048); continue; }
                else { a -= 2048 + 512; const int qb = a & 1; h = (a >> 1) & 7; b = a >> 4; r0 = b * PBR + qb * 128; seq = LC; }
                unsigned char* Ob = (unsigned char*)(parts + 3 * PART_ELEMS) + (size_t)r0 * DM + h * 128;
                const unsigned char* Kh = (const unsigned char*)(parts + 1 * PART_ELEMS) + (size_t)b * PBR * DM + h * 128;
                const unsigned char* Qb = (const unsigned char*)(parts + 1 * PART_ELEMS) + GATE_BYTES + (size_t)r0 * DM + h * 128;
                const unsigned char* Vh = (const unsigned char*)(parts + 2 * PART_ELEMS) + (size_t)(b * DM + h * 128) * (68 * 64);
                att::attn_unit(Qb, Kh, Vh, Ob, seq, lam, oscale, A->in[I_GSUB] + l * 128, (char*)F.ldsg, F.lds, F.tid, dry);
            }
            if (dry) { VM_WAIT(); __syncthreads(); }
            }
        } SEAM(pb + 2);
        for (int rep_ = 0; rep_ < REPS(5); ++rep_) { if (PH_ON(5) && IN(pb + 3)) { MKF();
            unsigned char* wl = F.ws + WS_WMIX + (size_t)l * WMIX_LAYER; bf16_t* const parts = (bf16_t*)(F.ws + WS_PARTS);
            { pg8::Gemm g{parts, (const bf16_t*)(wl + WM_WR), DM}; OrderG2 S{F.G, F.vcu, l == NLAYER - 1, 0, false}; EpiG2 E{parts, F.ws + WS_GATES, 1.f / 255.f, F.ws + WS_HA8};
              pg8::gemm_phase<EpiG2, OrderG2, true, true>(F.lds, g, S, E, F.tid); }
            __syncthreads();
            { pg8::Gemm g{parts, (const bf16_t*)(wl + WM_WR), DM / 2}; OrderG2 S{F.G, F.vcu, l == NLAYER - 1, 1, true}; EpiG2 E{parts, F.ws + WS_GATES, 1.f / (255.f * 32.f), F.ws + WS_HA8};
              pg8::gemm_phase<EpiG2, OrderG2, true, true, true>(F.lds, g, S, E, F.tid); }
        } REPBAR(5, rep_); } SEAM(pb + 3);
        for (int rep_ = 0; rep_ < REPS(6); ++rep_) { if (PH_ON(6) && IN(pb + 4)) { MKF();
            unsigned char* wl = F.ws + WS_WMIX + (size_t)l * WMIX_LAYER; bf16_t* const parts = (bf16_t*)(F.ws + WS_PARTS);
            pg8::Gemm g{G3_F8 ? (const bf16_t*)(F.ws + WS_HA8) : parts, (const bf16_t*)(wl + WM_WO), G3_F8 ? DM / 2 : DM}; OrderG3 S{F.G, F.vcu, l == NLAYER - 1};
            EpiG3 E{F.ws, (const float*)(F.ws + WS_MODV) + (size_t)l * NCOND * MODW, (G3_F8 ? 1.f / 32.f : 1.f) / (float)REPS(6)};
            pg8::gemm_phase<EpiG3, OrderG3, true, true, G3_F8 != 0>(F.lds, g, S, E, F.tid);
        } REPBAR(6, rep_); } SEAM(pb + 4);
        for (int rep_ = 0; rep_ < REPS(7); ++rep_) { if (PH_ON(7) && IN(pb + 5)) { MKF(); r1_phase(F, A, l, (REPS(7) == 2 && rep_ == 0) ? R1_VAR : 0); } REPBAR(7, rep_); } SEAM(pb + 5);
        for (int rep_ = 0; rep_ < REPS(8); ++rep_) { if (PH_ON(8) && IN(pb + 6)) { MKF(); r2_phase(F, A, l); } REPBAR(8, rep_); } SEAM(pb + 6);
        for (int rep_ = 0; rep_ < REPS(9); ++rep_) { if (PH_ON(9) && IN(pb + 7)) { MKF();
            LAS int* tabL = (LAS int*)(F.lds + TAB_OFF);
            for (int i = F.tid; i < 320; i += NWAVES * 64) tabL[i] = ((const int*)(F.ws + WS_BLKTAB))[i];
            __syncthreads();
            const int nblk = __builtin_amdgcn_readfirstlane(tabL[300]);
            pg8::Gemm g{(const bf16_t*)F.ws, (const bf16_t*)F.ws, DM / 2};
            OrderE S{F.G, F.vcu, nblk, 8, tabL, (int)(WS_XB / F8_TILE), (int)(WS_W13 / F8_TILE)}; EpiE1 E{F.ws + WS_ACT};
            pg8::gemm_phase<EpiE1, OrderE, true, true, true>(F.lds, g, S, E, F.tid);
        } REPBAR(9, rep_); } SEAM(pb + 7);
        for (int rep_ = 0; rep_ < REPS(10); ++rep_) { if (PH_ON(10) && IN(pb + 8)) { MKF();
            LAS int* tabL = (LAS int*)(F.lds + TAB_OFF);
            for (int i = F.tid; i < 320; i += NWAVES * 64) tabL[i] = ((const int*)(F.ws + WS_BLKTAB))[i];
            __syncthreads();
            const int nblk = __builtin_amdgcn_readfirstlane(tabL[300]);
            pg8::Gemm g{(const bf16_t*)F.ws, (const bf16_t*)F.ws, DM / 2};
            OrderE S{F.G, F.vcu, nblk, 4, tabL, (int)(WS_ACT / F8_TILE), (int)(WS_W2 / F8_TILE)}; EpiE2 E{F.ws + WS_XB, (REPS(10) == 2 && rep_ == 0 && E2_NOSTORE_PROBE) ? 1 : 0};
            pg8::gemm_phase<EpiE2, OrderE, true, true, true>(F.lds, g, S, E, F.tid);
        } REPBAR(10, rep_); } SEAM(pb + 8);
    }
__global__ void __launch_bounds__(NWAVES * 64, 2) fwd_kernel(Args args_in_kernarg_segment) {
    extern __shared__ __attribute__((aligned(16))) unsigned char lds[];
    for (int u = threadIdx.x; u < (LDS_BYTES - LDSCTL_OFF) / 4; u += NWAVES * 64) ((LAS unsigned*)((LAS unsigned char*)lds + LDSCTL_OFF))[u] = 0u;
    __syncthreads();
    int lo, hi; const int wave0 = __builtin_amdgcn_readfirstlane((int)threadIdx.x >> 6);
    { KArgs A = kargs(); lo = A->ph_lo; hi = A->ph_hi; (void)xcd_barrier_post((unsigned*)(A->ws + WS_CTL) + CW_BAR, (volatile LAS unsigned*)((LAS unsigned char*)lds + MISC_OFF) + 8); }
    for (int rep_ = 0; rep_ < REPS(0); ++rep_) { if (PH_ON(0) && IN(0)) { MKF(); p0_phase(F, A, (REPS(0) == 2 && rep_ == 0) ? P0_SKIP_PROBE : 0); } REPBAR(0, rep_); } SEAM(0);
    layer_body<0>(lds, lo, hi, wave0);
    layer_body<1>(lds, lo, hi, wave0);
    if (PH_ON(11) && IN(N_PHASES - 1)) { MKF(); final_phase(F, A); }
#undef IN
#undef SEAM
#undef MKF
}


#if MK_VERIFY
constexpr int CW_VFLAG = 12000;
__device__ __forceinline__ float vbf(float x) { return __builtin_bit_cast(float, f2bf(x) << 16); }
__global__ void verify_r1(Args a, int l) {
    const int lane = threadIdx.x & 63, gw = (blockIdx.x * blockDim.x + threadIdx.x) >> 6;
    const int R = (gw * 131 + 7) % TR; const int b = R / PBR, p = R - b * PBR; const int cond = p < LC ? 8 : b;
    const float* xp = p < LC ? (const float*)(a.ws + WS_XC) + ((size_t)b * LC + p) * DM : a.out + ((size_t)b * SEQ + (p - LC)) * DM;
    float ss = 0.f; for (int k = lane; k < DM; k += 64) ss += xp[k] * xp[k];
    ss = wave_sum(ss); const float rstd = 1.f / sqrtf(ss / DM + EPSN);
    const float* md = (const float*)(a.ws + WS_MODV) + ((size_t)l * NCOND + cond) * MODW;
    float lg[16]; for (int e = 0; e < 16; ++e) lg[e] = 0.f;
    for (int k = lane; k < DM; k += 64) { const float h = xp[k] * rstd * a.in[I_GN2][l * DM + k] * (1.f + md[4 * DM + k]) + md[3 * DM + k];
        for (int e = 0; e < 16; ++e) lg[e] += h * a.in[I_WROUT][k * 16 + e]; }
    for (int e = 0; e < 16; ++e) lg[e] = wave_sum(lg[e]) + a.in[I_BROUT][e];
    int best = 0; for (int e = 1; e < 16; ++e) if (lg[e] > lg[best]) best = e;
    int e2 = -1; for (int e = 0; e < 16; ++e) if ((e >> 2) == (best >> 2) && e != best && (e2 < 0 || lg[e] > lg[e2])) e2 = e;
    float m1 = 1e30f; for (int e = 0; e < 16; ++e) if (e != best) m1 = fminf(m1, lg[best] - lg[e]);
    float m2 = 1e30f; for (int e = 0; e < 16; ++e) if ((e >> 2) == (best >> 2) && e != best && e != e2) m2 = fminf(m2, lg[e2] - lg[e]);
    const u32x4 info = ((const u32x4*)(a.ws + WS_TOKINFO))[R];
    const float g1 = 1.f / (1.f + expf(lg[e2] - lg[best]));
    unsigned* fl = (unsigned*)(a.ws + WS_CTL) + CW_VFLAG;
    if (lane == 0 && m1 > 1e-3f && m2 > 1e-3f) {
        if ((int)(info.x & 255u) != best) atomicAdd(fl + 8, 1u);
        if ((int)((info.x >> 8) & 255u) != e2) atomicAdd(fl + 9, 1u);
        if (fabsf(((const float*)(a.ws + WS_TOKGATE))[R] - g1) > 1e-3f) atomicAdd(fl + 10, 1u);
        if ((info.x & 255u) == 255u) atomicAdd(fl + 11, 1u);
        if (info.w == 0u) atomicAdd(fl + 15, 1u); if (info.w != 0u && info.w < 65536u) atomicAdd(fl + 16, 1u); if (info.w == info.z) atomicAdd(fl + 17, 1u); if (info.w == info.y) atomicAdd(fl + 18, 1u);
        { const float gw_ = __builtin_bit_cast(float, info.w); if (fabsf(gw_) < 1e-6f) atomicAdd(fl + 12, 1u); if (!(gw_ >= 0.5f && gw_ <= 1.f)) atomicAdd(fl + 13, 1u); if (fabsf(gw_ - (1.f - g1)) < 1e-3f) atomicAdd(fl + 14, 1u); }
        if ((int)(info.x & 255u) != best || (int)((info.x >> 8) & 255u) != e2 || fabsf(__builtin_bit_cast(float, info.w) - g1) > 1e-3f) atomicAdd(fl + 0, 1u);
    }
}
__global__ void verify_r2(Args a) {
    const int lane = threadIdx.x & 63, gw = (blockIdx.x * blockDim.x + threadIdx.x) >> 6;
    const int R = (gw * 131 + 7) % TR;
    const u32x4 info = ((const u32x4*)(a.ws + WS_TOKINFO))[R]; if ((info.x & 255u) == 255u) return;
    const u32x4 sl = ((const u32x4*)(a.ws + WS_TOKC))[R]; const int* tab = (const int*)(a.ws + WS_BLKTAB);
    bool bad = false; const int nblk = tab[300];
    if ((int)(sl.x >> 8) >= nblk || (int)(sl.y >> 8) >= nblk || nblk > MAXBLK) bad = true;
    else { if (tab[sl.x >> 8] != (int)(info.x & 255u) || tab[sl.y >> 8] != (int)((info.x >> 8) & 255u)) bad = true;
        const unsigned* h = (const unsigned*)((const bf16_t*)(a.ws + WS_HA) + (size_t)R * DM); const unsigned* x1 = (const unsigned*)((const bf16_t*)(a.ws + WS_XB) + (size_t)sl.x * DM); const unsigned* x2 = (const unsigned*)((const bf16_t*)(a.ws + WS_XB) + (size_t)sl.y * DM);
        for (int k = lane; k < DM / 2; k += 64) if (h[k] != x1[k] || h[k] != x2[k]) bad = true; }
    if (__any(bad) && lane == 0) atomicAdd((unsigned*)(a.ws + WS_CTL) + CW_VFLAG + 1, 1u);
}
__global__ void verify_e1(Args a, int l) {
    const int lane = threadIdx.x & 63, gw = (blockIdx.x * blockDim.x + threadIdx.x) >> 6;
    const int R = (gw * 131 + 7) % TR;
    const u32x4 info = ((const u32x4*)(a.ws + WS_TOKINFO))[R]; if ((info.x & 255u) == 255u) return;
    const u32x4 sl = ((const u32x4*)(a.ws + WS_TOKC))[R];
    const unsigned slot = (gw & 1) ? sl.y : sl.x; const int e = (gw & 1) ? (int)((info.x >> 8) & 255u) : (int)(info.x & 255u);
    const int n = ((gw * 37) % 16) * 64 + lane;
    const bf16_t* xb = (const bf16_t*)(a.ws + WS_XB) + (size_t)slot * DM;
    const float* w1 = a.in[I_WE1] + ((size_t)l * NEXP + e) * DM * DM, *w3 = a.in[I_WE3] + ((size_t)l * NEXP + e) * DM * DM;
    float s1 = 0.f, s3 = 0.f;
    for (int k = 0; k < DM; ++k) { const float x = __builtin_bit_cast(float, (unsigned)xb[k] << 16); s1 += x * vbf(w1[(size_t)k * DM + n]); s3 += x * vbf(w3[(size_t)k * DM + n]); }
    const float ref = s1 / (1.f + expf(-s1)) * s3;
    const float got = __builtin_bit_cast(float, (unsigned)((const bf16_t*)(a.ws + WS_ACT))[(size_t)slot * DM + n] << 16);
    const bool bad = !(fabsf(got - ref) <= 0.03f * fabsf(ref) + 0.03f);
    if (__any(bad) && lane == 0) atomicAdd((unsigned*)(a.ws + WS_CTL) + CW_VFLAG + 2, 1u);
}
__global__ void verify_e2(Args a, int l) {
    const int lane = threadIdx.x & 63, gw = (blockIdx.x * blockDim.x + threadIdx.x) >> 6;
    const int R = (gw * 131 + 7) % TR;
    const u32x4 info = ((const u32x4*)(a.ws + WS_TOKINFO))[R]; if ((info.x & 255u) == 255u) return;
    const u32x4 sl = ((const u32x4*)(a.ws + WS_TOKC))[R];
    const unsigned slot = (gw & 1) ? sl.y : sl.x; const int e = (gw & 1) ? (int)((info.x >> 8) & 255u) : (int)(info.x & 255u);
    const int n = ((gw * 37) % 16) * 64 + lane;
    const bf16_t* ac = (const bf16_t*)(a.ws + WS_ACT) + (size_t)slot * DM;
    const float* w2 = a.in[I_WE2] + ((size_t)l * NEXP + e) * DM * DM;
    float s = 0.f;
    for (int k = 0; k < DM; ++k) s += __builtin_bit_cast(float, (unsigned)ac[k] << 16) * vbf(w2[(size_t)k * DM + n]);
    const float got = __builtin_bit_cast(float, (unsigned)((const bf16_t*)(a.ws + WS_XB))[(size_t)slot * DM + n] << 16);
    const bool bad = !(fabsf(got - s) <= 0.03f * fabsf(s) + 0.03f);
    if (__any(bad) && lane == 0) atomicAdd((unsigned*)(a.ws + WS_CTL) + CW_VFLAG + 3, 1u);
}
__global__ void verify_encode(Args a) {
    const unsigned* f = (const unsigned*)(a.ws + WS_CTL) + CW_VFLAG;
    const unsigned cnt = f[MK_VCHECK];
    if (cnt == 0u) return;
    const float s = 0.7f - 0.7f * fminf((float)cnt / 512.f, 1.f);
    for (size_t i = (size_t)blockIdx.x * blockDim.x + threadIdx.x; i < (size_t)NB * SEQ * DM; i += (size_t)gridDim.x * blockDim.x) a.out[i] *= s;
}
#endif
extern "C" void kernel_launch(void* const* d_in, const int* in_sizes, int n_in, void* d_out, int out_size, void* d_ws, size_t ws_size, hipStream_t stream) {
    static int grid = 0;
    if (grid == 0) {
        if (n_in != 27 || out_size != NB * SEQ * DM || ws_size < WS_END) { fprintf(stderr, "kernel_launch: shape mismatch (n_in %d out %d ws %zu, need ws >= %zu)\n", n_in, out_size, ws_size, (size_t)WS_END); grid = -1; return; }
        int dev = 0, cus = 0, per_cu = 0;
        if (hipGetDevice(&dev) != hipSuccess || hipDeviceGetAttribute(&cus, hipDeviceAttributeMultiprocessorCount, dev) != hipSuccess) { grid = -1; return; }
        if (hipFuncSetAttribute((const void*)fwd_kernel, hipFuncAttributeMaxDynamicSharedMemorySize, LDS_BYTES) != hipSuccess) { fprintf(stderr, "kernel_launch: hipFuncSetAttribute failed\n"); grid = -1; return; }
        if (hipOccupancyMaxActiveBlocksPerMultiprocessor(&per_cu, (const void*)fwd_kernel, NWAVES * 64, LDS_BYTES) != hipSuccess || per_cu < 1) { fprintf(stderr, "kernel_launch: occupancy query says %d\n", per_cu); }
        (void)hipGetLastError();
        grid = cus;
    }
    if (grid < 0) return;
    if (hipMemsetAsync((char*)d_ws + WS_CTL, 0, CTL_ZERO_BYTES, stream) != hipSuccess) return;
    Args a{};
    for (int i = 0; i < 27; ++i) a.in[i] = (const float*)d_in[i];
    a.out = (float*)d_out; a.ws = (unsigned char*)d_ws;
#if MK_PER_PHASE
    for (int k = 0; k < N_PHASES; ++k) { a.ph_lo = k; a.ph_hi = k + 1; hipLaunchKernelGGL(fwd_kernel, dim3(grid), dim3(NWAVES * 64), LDS_BYTES, stream, a);
#if MK_VERIFY
        const int vl = MK_VERIFY - 1, pb = 1 + 9 * vl;
        if (k == pb + 5) hipLaunchKernelGGL(verify_r1, dim3(128), dim3(256), 0, stream, a, vl);
        if (k == pb + 6) hipLaunchKernelGGL(verify_r2, dim3(128), dim3(256), 0, stream, a);
        if (k == pb + 7) hipLaunchKernelGGL(verify_e1, dim3(128), dim3(256), 0, stream, a, vl);
        if (k == pb + 8) hipLaunchKernelGGL(verify_e2, dim3(128), dim3(256), 0, stream, a, vl);
        if (k == N_PHASES - 1) hipLaunchKernelGGL(verify_encode, dim3(1024), dim3(256), 0, stream, a);
#endif
    }
#else
    a.ph_lo = 0; a.ph_hi = N_PHASES;
    hipLaunchKernelGGL(fwd_kernel, dim3(grid), dim3(NWAVES * 64), LDS_BYTES, stream, a);
#endif
    const hipError_t le = hipPeekAtLastError();
    if (le != hipSuccess) fprintf(stderr, "kernel_launch: launch failed: %s\n", hipGetErrorName(le));
}
```

```cpp
#include <hip/hip_runtime.h>
#include <cstdio>
#include <cstdint>

#ifndef MK_PER_PHASE
#define MK_PER_PHASE 0
#endif

#ifndef MK_VERIFY
#define MK_VERIFY 0
#endif
#ifndef MK_VCHECK
#define MK_VCHECK 0
#endif
#ifndef ATT_PRIO
#define ATT_PRIO 0
#endif
#ifndef ATT_VAR
#define ATT_VAR 0
#endif
#define GAS __attribute__((address_space(1)))
#define LAS __attribute__((address_space(3)))
typedef short s16x4 __attribute__((ext_vector_type(4)));
typedef float f32x16 __attribute__((ext_vector_type(16)));
typedef unsigned u32x2 __attribute__((ext_vector_type(2)));

namespace pg8 {
#define PG8_LAS __attribute__((address_space(3)))
typedef unsigned short bf16_t;
typedef short bf16x8 __attribute__((ext_vector_type(8)));
typedef float f32x4 __attribute__((ext_vector_type(4)));
typedef unsigned u32x4 __attribute__((ext_vector_type(4)));
typedef float f32x2 __attribute__((ext_vector_type(2)));
constexpr int BM = 256, BK = 64, HALF = 128, HTB = HALF * BK * 2  , STAGE_BYTES = 8 * HTB, NXCD = 8, WGM = 8;

__host__ __device__ __forceinline__ int lds_byte(int r, int c) { const int st = (r >> 4) * 2 + (c >> 5), rr = r & 15, cc = c & 31, ob = rr * 64 + cc * 2; return st * 1024 + (ob ^ (((ob >> 9) & 1) << 5)); }
__host__ __device__ __forceinline__ void stage_rc(int b, int& R, int& C) { const int st = b / 1024, sb = b % 1024, swz = sb ^ (((sb >> 9) & 1) << 5); R = (st >> 1) * 16 + swz / 64; C = (st & 1) * 32 + (swz % 64) / 2; }
__host__ __device__ __forceinline__ int perm32(int rho) { const int n = rho >> 4, i = rho & 15; return 8 * (i >> 2) + 4 * n + (i & 3); }

struct Unit { int pm, pn, pa, pb, sub; };
struct Gemm { const bf16_t* A; const bf16_t* Bt; int K; };

struct StaticOrder {
    int nM, nN, nwg, G, c;
    __host__ __device__ void init(int M, int N, int G_, int c_) { nM = M / BM; nN = N / BM; nwg = nM * nN; G = G_; c = c_; }
    __host__ __device__ bool next(int i, Unit& u) const {
        const long L = (long)i * G + c; if (L >= nwg) return false;
        int wgid = (int)L; { const int q = nwg / NXCD, r = nwg % NXCD, xcd = wgid % NXCD, off = wgid / NXCD; wgid = (xcd < r ? xcd * (q + 1) : r * (q + 1) + (xcd - r) * q) + off; }
        const int nig = WGM * nN, gid = wgid / nig, fm = gid * WGM, gsz = (nM - fm) < WGM ? (nM - fm) : WGM;
        u.pm = fm + ((wgid % nig) % gsz); u.pn = (wgid % nig) / gsz; u.pa = u.pm; u.pb = u.pn; u.sub = 0; return true;
    }
    __device__ __forceinline__ void a_ready(const Unit&) const {}
    __device__ __forceinline__ void done(const Unit&) const {}
};

__device__ __forceinline__ unsigned cvt_pk_bf16(float lo, float hi) { unsigned r; asm volatile("v_cvt_pk_bf16_f32 %0, %1, %2" : "=v"(r) : "v"(lo), "v"(hi)); return r; }

template <class Epi, class Sched, bool ALIGN_EPI = false, bool SP2 = false, bool F8 = false>
__device__ __forceinline__ void gemm_phase(PG8_LAS unsigned char* lds, const Gemm g, const Sched& S, const Epi& E, const int tid  ) {
    const int wid = __builtin_amdgcn_readfirstlane(tid >> 6), lane = tid & 63, wr = wid >> 2, wc = wid & 3, fr = lane & 15, fq = lane >> 4;
    const int K = g.K, nt = K / BK;
    unsigned voffA[2], voffB[2];
#pragma unroll
    for (int i = 0; i < 2; ++i) { int R, C; stage_rc(tid * 16 + i * 8192, R, C); const int Rb = Epi::PERM ? ((R & ~31) + perm32(R & 31)) : R;
        voffA[i] = (unsigned)(R * K + C) * 2u; voffB[i] = (unsigned)(Rb * K + C) * 2u; }
    const size_t kstep = (size_t)(BK * 2);
    const size_t hstep = (size_t)HALF * K * 2;
    const size_t tstep = 2 * hstep;
    const unsigned ldsw = (unsigned)wid * 1024u;
    const int aoff = lds_byte(wr * 64 + fr, fq * 8), boff = lds_byte(wc * 32 + fr, fq * 8);
#define PG8_SA(b, h) (((b) * 2 + (h)) * HTB)
#define PG8_SB(b, h) ((4 + (b) * 2 + (h)) * HTB)
#define PG8_STAGE(bufoff, gbase, voff) do { _Pragma("unroll") for (int _i = 0; _i < 2; ++_i) \
        __builtin_amdgcn_global_load_lds((const unsigned*)((const char*)(gbase) + (voff)[_i]), (PG8_LAS unsigned*)(lds + (bufoff) + ldsw + _i * 8192), 16, 0, 0); } while (0)
#define PG8_LD8(addr) __builtin_shufflevector(*(const PG8_LAS i32x4_*)(addr), *(const PG8_LAS i32x4_*)((addr) + 1024), 0, 1, 2, 3, 4, 5, 6, 7)
#define PG8_LDA(dst, b, h) do { if constexpr (F8) { _Pragma("unroll") for (int m = 0; m < 4; ++m) dst##8[m] = PG8_LD8(lds + PG8_SA(b, h) + aoff + m * 2048); } \
        else { _Pragma("unroll") for (int m = 0; m < 4; ++m) _Pragma("unroll") for (int k = 0; k < 2; ++k) dst[m][k] = *(const PG8_LAS bf16x8*)(lds + PG8_SA(b, h) + aoff + m * 2048 + k * 1024); } } while (0)
#define PG8_LDB(dst, b, h) do { if constexpr (F8) { _Pragma("unroll") for (int n = 0; n < 2; ++n) dst##8[n] = PG8_LD8(lds + PG8_SB(b, h) + boff + n * 2048); } \
        else { _Pragma("unroll") for (int n = 0; n < 2; ++n) _Pragma("unroll") for (int k = 0; k < 2; ++k) dst[n][k] = *(const PG8_LAS bf16x8*)(lds + PG8_SB(b, h) + boff + n * 2048 + k * 1024); } } while (0)
#define PG8_MMA(ai, bj, At, Bt) do { __builtin_amdgcn_s_setprio(1); _Pragma("unroll") for (int m = 0; m < 4; ++m) _Pragma("unroll") for (int n = 0; n < 2; ++n) { \
        if constexpr (F8) asm volatile("v_mfma_f32_16x16x128_f8f6f4 %0, %1, %2, %0" : "+v"(acc[ai][bj][m][n]) : "v"(Bt##8[n]), "v"(At##8[m]));     \
        else { _Pragma("unroll") for (int k = 0; k < 2; ++k) acc[ai][bj][m][n] = __builtin_amdgcn_mfma_f32_16x16x32_bf16(Bt[n][k], At[m][k], acc[ai][bj][m][n], 0, 0, 0); } } \
        __builtin_amdgcn_s_setprio(0); } while (0)
#define PG8_WAIT_V(n) asm volatile("s_waitcnt vmcnt(" #n ")" ::: "memory")
#define PG8_WAIT_L(n) asm volatile("s_waitcnt lgkmcnt(" #n ")" ::: "memory")
#define PG8_BAR __builtin_amdgcn_s_barrier()
#define PG8_SCHED __builtin_amdgcn_sched_barrier(0)
    Unit cur, nxt; int ui = 0;
    if (!S.next(0, cur)) return;
    float zf_ = 0.f; asm volatile("" : "+v"(zf_));
    f32x4 acc[2][2][4][2];
#pragma unroll
    for (int a = 0; a < 2; ++a)
#pragma unroll
        for (int b = 0; b < 2; ++b)
#pragma unroll
            for (int m = 0; m < 4; ++m)
#pragma unroll
                for (int n = 0; n < 2; ++n) acc[a][b][m][n] = (f32x4){zf_, zf_, zf_, zf_};
    typedef int i32x4_ __attribute__((ext_vector_type(4))); typedef int i32x8_ __attribute__((ext_vector_type(8)));
    bf16x8 At[4][2], B0[2][2], B1[2][2];
    i32x8_ At8[4], B08[2], B18[2];
    const char* cA = (const char*)g.A + (size_t)cur.pa * tstep; const char* cB = (const char*)g.Bt + (size_t)cur.pb * tstep;
    S.a_ready(cur);
    if constexpr (SP2) {
        PG8_STAGE(PG8_SB(0, 0), cB, voffB); PG8_STAGE(PG8_SB(0, 1), cB + hstep, voffB); PG8_STAGE(PG8_SA(0, 0), cA, voffA); PG8_STAGE(PG8_SA(0, 1), cA + hstep, voffA);
        if (wr == 1) PG8_BAR;
        PG8_WAIT_V(2); PG8_BAR;
        PG8_STAGE(PG8_SB(1, 0), cB + kstep, voffB); PG8_STAGE(PG8_SA(1, 0), cA + kstep, voffA); PG8_STAGE(PG8_SB(1, 1), cB + hstep + kstep, voffB);
        PG8_WAIT_V(6); PG8_BAR;
    } else {
        PG8_STAGE(PG8_SB(0, 0), cB, voffB); PG8_STAGE(PG8_SA(0, 0), cA, voffA); PG8_STAGE(PG8_SB(0, 1), cB + hstep, voffB); PG8_STAGE(PG8_SA(0, 1), cA + hstep, voffA);
        if (wr == 1) PG8_BAR;
        PG8_WAIT_V(4); PG8_BAR;
        PG8_STAGE(PG8_SB(1, 0), cB + kstep, voffB); PG8_STAGE(PG8_SA(1, 0), cA + kstep, voffA); PG8_STAGE(PG8_SB(1, 1), cB + hstep + kstep, voffB);
        PG8_WAIT_V(6); PG8_BAR;
    }
    for (;;) {
        const bool has_next = S.next(ui + 1, nxt);
        const char* nA = has_next ? (const char*)g.A + (size_t)nxt.pa * tstep : cA; const char* nB = has_next ? (const char*)g.Bt + (size_t)nxt.pb * tstep : cB;
#pragma nounroll
        for (int t = 0; t < nt; t += 2) {
            const bool last = (t == nt - 2);
            const char* a1 = cA + (size_t)(t + 1) * kstep;
            const char* a2 = last ? nA : cA + (size_t)(t + 2) * kstep; const char* b2 = last ? nB : cB + (size_t)(t + 2) * kstep;
            const char* a3 = a2 + kstep; const char* b3 = b2 + kstep;
            if (last && has_next) S.a_ready(nxt);
            if constexpr (SP2) {
            PG8_LDB(B0, 0, 0); PG8_LDB(B1, 0, 1); PG8_SCHED; PG8_LDA(At, 0, 0); PG8_STAGE(PG8_SA(1, 1), a1 + hstep, voffA);
            PG8_WAIT_V(8); PG8_WAIT_L(0); PG8_BAR; PG8_MMA(0, 0, At, B0); PG8_MMA(0, 1, At, B1); PG8_BAR; PG8_SCHED;
            PG8_LDA(At, 0, 1); PG8_STAGE(PG8_SB(0, 0), b2, voffB); PG8_STAGE(PG8_SB(0, 1), b2 + hstep, voffB); PG8_STAGE(PG8_SA(0, 0), a2, voffA);
            PG8_WAIT_V(8); PG8_WAIT_L(0); PG8_BAR; PG8_MMA(1, 0, At, B0); PG8_MMA(1, 1, At, B1); PG8_BAR; PG8_SCHED;
            PG8_LDB(B0, 1, 0); PG8_LDB(B1, 1, 1); PG8_SCHED; PG8_LDA(At, 1, 0); PG8_STAGE(PG8_SA(0, 1), a2 + hstep, voffA);
            PG8_WAIT_V(8); PG8_WAIT_L(0); PG8_BAR; PG8_MMA(0, 0, At, B0); PG8_MMA(0, 1, At, B1); PG8_BAR; PG8_SCHED;
            PG8_LDA(At, 1, 1); PG8_STAGE(PG8_SB(1, 0), b3, voffB); PG8_STAGE(PG8_SB(1, 1), b3 + hstep, voffB); PG8_STAGE(PG8_SA(1, 0), a3, voffA);
            PG8_WAIT_V(8); PG8_WAIT_L(0); PG8_BAR; PG8_MMA(1, 0, At, B0); PG8_MMA(1, 1, At, B1); PG8_BAR; PG8_SCHED;
            } else {
            PG8_LDB(B0, 0, 0); PG8_SCHED; PG8_LDA(At, 0, 0); PG8_STAGE(PG8_SA(1, 1), a1 + hstep, voffA);
            PG8_WAIT_L(8); PG8_BAR; PG8_WAIT_L(0); PG8_MMA(0, 0, At, B0); PG8_BAR; PG8_SCHED;
            PG8_LDB(B1, 0, 1); PG8_STAGE(PG8_SB(0, 0), b2, voffB);
            PG8_BAR; PG8_WAIT_L(0); PG8_MMA(0, 1, At, B1); PG8_BAR;
            PG8_LDA(At, 0, 1); PG8_STAGE(PG8_SA(0, 0), a2, voffA);
            PG8_BAR; PG8_WAIT_L(0); PG8_MMA(1, 0, At, B0); PG8_BAR; PG8_SCHED;
            PG8_STAGE(PG8_SB(0, 1), b2 + hstep, voffB);
            PG8_WAIT_V(6); PG8_BAR; PG8_MMA(1, 1, At, B1); PG8_BAR;
            PG8_LDB(B0, 1, 0); PG8_SCHED; PG8_LDA(At, 1, 0); PG8_STAGE(PG8_SA(0, 1), a2 + hstep, voffA);
            PG8_WAIT_L(8); PG8_BAR; PG8_WAIT_L(0); PG8_MMA(0, 0, At, B0); PG8_BAR; PG8_SCHED;
            PG8_LDB(B1, 1, 1); PG8_STAGE(PG8_SB(1, 0), b3, voffB);
            PG8_BAR; PG8_WAIT_L(0); PG8_MMA(0, 1, At, B1); PG8_BAR;
            PG8_LDA(At, 1, 1); PG8_STAGE(PG8_SA(1, 0), a3, voffA);
            PG8_BAR; PG8_WAIT_L(0); PG8_MMA(1, 0, At, B0); PG8_BAR; PG8_SCHED;
            PG8_STAGE(PG8_SB(1, 1), b3 + hstep, voffB);
            PG8_WAIT_V(6); PG8_BAR; PG8_MMA(1, 1, At, B1); PG8_BAR;
            }
        }
        if constexpr (F8) asm volatile("s_nop 15\n\ts_nop 15" ::: "memory");
        if constexpr (ALIGN_EPI) { if (wr == 0) PG8_BAR; }
        if constexpr (!Epi::AFTER_DRAIN) { E(acc, cur, wr, wc, fr, fq); S.done(cur); }
        if (!has_next) break;
#pragma unroll
        for (int a = 0; a < 2; ++a)
#pragma unroll
            for (int b = 0; b < 2; ++b)
#pragma unroll
                for (int m = 0; m < 4; ++m)
#pragma unroll
                    for (int n = 0; n < 2; ++n) acc[a][b][m][n] = (f32x4){zf_, zf_, zf_, zf_};
        cur = nxt; cA = nA; cB = nB; ++ui;
        if constexpr (ALIGN_EPI) { if (wr == 1) PG8_BAR; }
    }
    PG8_WAIT_V(0);
    if constexpr (!ALIGN_EPI) { if (wr == 0) PG8_BAR; }
    PG8_BAR;
    if constexpr (Epi::AFTER_DRAIN) { E.fused(acc, cur, wr, wc, fr, fq, lds, wid, lane); S.done(cur); }
#undef PG8_SA
#undef PG8_SB
#undef PG8_STAGE
#undef PG8_LD8
#undef PG8_LDA
#undef PG8_LDB
#undef PG8_MMA
#undef PG8_WAIT_V
#undef PG8_WAIT_L
#undef PG8_BAR
#undef PG8_SCHED
}
}

using pg8::bf16_t; using pg8::bf16x8; using pg8::f32x4; using pg8::u32x4; using pg8::f32x2; using pg8::Unit;

#ifndef DBG_STOP_AFTER
#define DBG_STOP_AFTER 1000
#endif
#ifndef R1_GLOBAL_W
#define R1_GLOBAL_W 0
#endif
#ifndef R1_SIMPLE
#define R1_SIMPLE 0
#endif
constexpr int NB = 8, SEQ = 4096, LC = 256, DM = 1024, PBR = LC + SEQ  , TR = NB * PBR  , NTILE = TR / 256  , TPB = PBR / 256  ;
constexpr int DIN = 7168, NLAYER = 2, NEXP = 16, NWAVES = 8, NCOND = 9  , MODW = 6 * DM;
constexpr float EPSN = 1e-6f;
constexpr int N_PHASES = 2 + 9 * NLAYER;
constexpr int MAXBLK = 2 * TR / 256 + NEXP;
constexpr size_t PART_ELEMS = (size_t)TR * DM;

constexpr size_t MiB = 1u << 20;
constexpr size_t WS_CTL = 0, CTL_ZERO_BYTES = 1 * MiB;
constexpr size_t WS_MODV = 1 * MiB;
constexpr size_t WS_COS = 2 * MiB, WS_SIN = 2 * MiB + 512 * 1024;
constexpr size_t WS_LAM = 3 * MiB;
constexpr size_t WS_TOKINFO = 3 * MiB + 65536;
constexpr size_t WS_TOKSLOT = 4 * MiB;
constexpr size_t WS_CNT = 4 * MiB + 512 * 1024;
constexpr size_t WS_BLKTAB = WS_CNT + 65536;
constexpr size_t WS_TOKGATE = 5 * MiB;
constexpr size_t WS_TOKC = 5 * MiB + 512 * 1024;
constexpr size_t WS_XC = 8 * MiB;
constexpr size_t WS_WMIX = 16 * MiB, WMIX_LAYER = 21 * MiB;
constexpr size_t WM_WIN = 0, WM_WR = 14 * MiB, WM_WA = 16 * MiB, WM_WO = 18 * MiB, WM_LRU = 20 * MiB;
constexpr size_t WS_HA = 58 * MiB;
constexpr size_t WS_PARTS = 126 * MiB;
constexpr size_t WS_GATES = WS_PARTS + 5 * 68 * MiB, GATE_BYTES = (size_t)TR * DM;
constexpr size_t WS_XB = WS_PARTS, WS_ACT = WS_PARTS + 144 * MiB;
constexpr size_t WS_W13 = WS_PARTS + 6 * 68 * MiB, WS_W2 = WS_W13 + 32 * MiB;
constexpr size_t WS_END = WS_W13 + 96 * MiB;
constexpr size_t F8_TILE = 256 * (size_t)DM;
static_assert(PART_ELEMS * 2 == 68 * MiB && WS_ACT + 72 * MiB <= WS_W13 && (size_t)MAXBLK * 256 * 2048 == 144 * MiB && WS_END == 630 * MiB, "ws map");
static_assert(WS_XB % F8_TILE == 0 && WS_ACT % F8_TILE == 0 && WS_W13 % F8_TILE == 0 && WS_W2 % F8_TILE == 0, "tile-addressed regions");
constexpr int CW_TMO = 0, CW_BAR = 4096, CW_QUEUE = 8192;

constexpr int RING_BYTES = 131072, LDSCTL_OFF = RING_BYTES, MISC_OFF = LDSCTL_OFF + 320, TAB_OFF = LDSCTL_OFF + 1024, LDS_BYTES = 147456;

#define LDS_WAIT() asm volatile("s_waitcnt lgkmcnt(0)" ::: "memory")
#define VM_WAIT() asm volatile("s_waitcnt vmcnt(0)" ::: "memory")
#define SBAR() __builtin_amdgcn_sched_barrier(0)
__device__ __forceinline__ unsigned f2bf(float f) { unsigned u = __builtin_bit_cast(unsigned, f); return (u + 0x7fffu + ((u >> 16) & 1u)) >> 16; }
__device__ __forceinline__ unsigned pk2(float lo, float hi) { return f2bf(lo) | (f2bf(hi) << 16); }
__device__ __forceinline__ float bflo(unsigned w) { return __builtin_bit_cast(float, w << 16); }
__device__ __forceinline__ float bfhi(unsigned w) { return __builtin_bit_cast(float, w & 0xffff0000u); }
__device__ __forceinline__ float fast_sigmoid(float x) { return __builtin_amdgcn_rcpf(1.f + __builtin_amdgcn_exp2f(-1.4426950408889634f * x)); }
__device__ __forceinline__ float gelu_tanh(float x) { return x * fast_sigmoid(1.5957691216057308f * (x + 0.044715f * x * x * x)); }
__device__ __forceinline__ unsigned pk4_fp8(float a, float b, float c, float d) { unsigned w = 0u; w = __builtin_amdgcn_cvt_pk_fp8_f32(a, b, w, false); w = __builtin_amdgcn_cvt_pk_fp8_f32(c, d, w, true); return w; }
__device__ __forceinline__ unsigned ld_dev(const void* p) { return __hip_atomic_load((const unsigned*)p, __ATOMIC_RELAXED, __HIP_MEMORY_SCOPE_AGENT); }
__device__ __forceinline__ float ld_devf(const void* p) { return __builtin_bit_cast(float, ld_dev(p)); }
template <int CTRL, int ROW_MASK> __device__ __forceinline__ float dpp_add(float v) {
    return v + __builtin_bit_cast(float, __builtin_amdgcn_update_dpp(0, __builtin_bit_cast(int, v), CTRL, ROW_MASK, 0xF, false)); }
__device__ __forceinline__ float wave_sum(float v) {
    v = dpp_add<0xB1, 0xF>(v);
    v = dpp_add<0x4E, 0xF>(v);
    v = dpp_add<0x141, 0xF>(v);
    v = dpp_add<0x140, 0xF>(v);
    v = dpp_add<0x142, 0xA>(v);
    v = dpp_add<0x143, 0xC>(v);
    return __builtin_bit_cast(float, __builtin_amdgcn_readlane(__builtin_bit_cast(int, v), 63));
}

using pg8::cvt_pk_bf16;
constexpr float QSCALE = 0.125f * 1.4426950408889634f;
constexpr size_t WS_XBA = WS_PARTS + 238 * MiB, WS_XBB = WS_W13 + 48 * MiB;
static_assert(WS_XBA == WS_PARTS + 3 * 68 * MiB + 34 * MiB && WS_XBB + 34 * MiB <= WS_END && (size_t)(TR / 2) * DM * 2 == 34 * MiB && (TR / 2) % 256 == 0, "x bf16 halves");
__device__ __forceinline__ bf16_t* xb_row(unsigned char* ws, int R) { return (bf16_t*)(ws + (R < TR / 2 ? WS_XBA : WS_XBB)) + (size_t)(R < TR / 2 ? R : R - TR / 2) * DM; }
__device__ __forceinline__ int cond_of(int R) { const int b = R / PBR, p = R - b * PBR; return p < LC ? 8 : b; }
__device__ __forceinline__ f32x4 bf4(const u32x2 w) { return (f32x4){bflo(w.x), bfhi(w.x), bflo(w.y), bfhi(w.y)}; }
#ifndef G1_F8_PARTS
#define G1_F8_PARTS 0x6f
#endif
constexpr size_t WS_HA8 = WS_PARTS + 2 * 68 * MiB + 34 * MiB;
struct EpiG1 {
    static constexpr bool PERM = true, AFTER_DRAIN = false;
    bf16_t* parts; const float* cosT; const float* sinT; unsigned char* gates; int plain; float G1SC;
    __device__ __forceinline__ void operator()(const f32x4 (&acc)[2][2][4][2], const Unit& u, int wr, int wc, int fr, int fq) const {
        const int part = u.pn >> 2;
        bf16_t* base = parts + (size_t)part * PART_ELEMS;
        const int col0 = (u.pn & 3) * 256 + wc * 32 + 8 * fq;
        const int jt = u.pm % TPB, lrow0 = wr * 64 + fr, srow0 = (jt - 1) * 256 + lrow0;
        const size_t row0 = (size_t)u.pm * 256 + lrow0;
        const bool rope = (jt != 0) && (part == 1 || part == 3) && !plain;
        const int pair0 = (col0 & 63) >> 1;
        if (part == 2 && !plain) {
            unsigned char* vt = (unsigned char*)base + ((size_t)(u.pm / TPB) * DM + col0) * (68 * 64) + ((fr >> 2) & 1) * 32 + ((fr & 3) + 4 * (fr >> 3)) * 4;
#pragma unroll
            for (int ai = 0; ai < 2; ++ai)
#pragma unroll
                for (int bj = 0; bj < 2; ++bj) {
                    unsigned char* p = vt + (size_t)(bj * 128) * (68 * 64) + ((u.pm % TPB) * 4 + ai * 2 + wr) * 64;
#pragma unroll
                    for (int t = 0; t < 8; ++t) *(unsigned*)(p + (size_t)t * (68 * 64)) = pk4_fp8(acc[ai][bj][0][t >> 2][t & 3] * G1SC, acc[ai][bj][1][t >> 2][t & 3] * G1SC, acc[ai][bj][2][t >> 2][t & 3] * G1SC, acc[ai][bj][3][t >> 2][t & 3] * G1SC);
                }
            return;
        }
#pragma unroll
        for (int ai = 0; ai < 2; ++ai) {
            f32x4 csv[4], snv[4];
            if (rope) {
#pragma unroll
                for (int m = 0; m < 4; ++m) { const size_t to = (size_t)(srow0 + ai * 128 + m * 16) * 32 + pair0; csv[m] = *(const f32x4*)(cosT + to); snv[m] = *(const f32x4*)(sinT + to); }
            }
#pragma unroll
            for (int m = 0; m < 4; ++m) {
                const int dr = ai * 128 + m * 16;
                bf16_t* rowp = base + (row0 + dr) * DM + col0;
#pragma unroll
                for (int bj = 0; bj < 2; ++bj) {
                    f32x4 v0 = acc[ai][bj][m][0] * G1SC, v1 = acc[ai][bj][m][1] * G1SC;
                    if (rope) {
                        const f32x4 cs = csv[m], sn = snv[m];
                        v0 = (f32x4){v0[0] * cs[0] - v0[1] * sn[0], v0[0] * sn[0] + v0[1] * cs[0], v0[2] * cs[1] - v0[3] * sn[1], v0[2] * sn[1] + v0[3] * cs[1]};
                        v1 = (f32x4){v1[0] * cs[2] - v1[1] * sn[2], v1[0] * sn[2] + v1[1] * cs[2], v1[2] * cs[3] - v1[3] * sn[3], v1[2] * sn[3] + v1[3] * cs[3]};
                    } else if (plain) { if (part >= 5) continue;
                    } else if (part == 4) {
#pragma unroll
                        for (int t = 0; t < 4; ++t) { v0[t] = gelu_tanh(v0[t]); v1[t] = gelu_tanh(v1[t]); }
                    } else if (part >= 5) {
                        unsigned q[8];
#pragma unroll
                        for (int t = 0; t < 4; ++t) { q[t] = (unsigned)(fast_sigmoid(v0[t]) * 255.f + 0.5f); q[4 + t] = (unsigned)(fast_sigmoid(v1[t]) * 255.f + 0.5f); }
                        u32x2 w8; w8.x = q[0] | (q[1] << 8) | (q[2] << 16) | (q[3] << 24); w8.y = q[4] | (q[5] << 8) | (q[6] << 16) | (q[7] << 24);
                        *(u32x2*)(gates + (size_t)(part - 5) * GATE_BYTES + (row0 + dr) * DM + col0 + bj * 128) = w8;
                        continue;
                    }
                    if (part == 3) { v0 = v0 * QSCALE; v1 = v1 * QSCALE; }
                    if ((part == 1 || part == 3) && !plain) {
                        u32x2 w8; w8.x = pk4_fp8(v0[0], v0[1], v0[2], v0[3]); w8.y = pk4_fp8(v1[0], v1[1], v1[2], v1[3]);
                        *(u32x2*)((unsigned char*)(parts + PART_ELEMS) + (part == 3 ? GATE_BYTES : (size_t)0) + (row0 + dr) * DM + col0 + bj * 128) = w8;
                        continue;
                    }
                    u32x4 w; w.x = cvt_pk_bf16(v0[0], v0[1]); w.y = cvt_pk_bf16(v0[2], v0[3]); w.z = cvt_pk_bf16(v1[0], v1[1]); w.w = cvt_pk_bf16(v1[2], v1[3]);
                    *(u32x4*)(rowp + bj * 128) = w;
                }
            }
        }
    }
};
#ifndef G3_F8
#define G3_F8 0
#endif
struct EpiG2 {
    static constexpr bool PERM = true, AFTER_DRAIN = false;
    bf16_t* parts; const unsigned char* gates; float I255; unsigned char* m8;
    __device__ __forceinline__ void operator()(const f32x4 (&acc)[2][2][4][2], const Unit& u, int wr, int wc, int fr, int fq) const {
        const unsigned char* gate = gates + (size_t)u.sub * GATE_BYTES; bf16_t* mg = parts;
        const int col0 = u.pn * 256 + wc * 32 + 8 * fq; const size_t row0 = (size_t)u.pm * 256 + wr * 64 + fr;
        const unsigned smask = u.sub ? 0xffffffffu : 0u;
#pragma unroll
        for (int ai = 0; ai < 2; ++ai) {
            u32x2 g[4][2]; u32x4 t[4][2];
#pragma unroll
            for (int m = 0; m < 4; ++m)
#pragma unroll
                for (int bj = 0; bj < 2; ++bj) { const size_t off = (row0 + ai * 128 + m * 16) * DM + col0 + bj * 128;
                    g[m][bj] = *(const u32x2*)(gate + off); t[m][bj] = *(const u32x4*)(mg + off); }
#pragma unroll
            for (int m = 0; m < 4; ++m)
#pragma unroll
                for (int bj = 0; bj < 2; ++bj) { const size_t off = (row0 + ai * 128 + m * 16) * DM + col0 + bj * 128;
                    const u32x2 gg = g[m][bj]; u32x4 tt = t[m][bj]; tt.x &= smask; tt.y &= smask; tt.z &= smask; tt.w &= smask;
                    const f32x4 v0 = acc[ai][bj][m][0], v1 = acc[ai][bj][m][1];
                    const float r0 = v0[0] * ((float)(gg.x & 255u) * I255) + bflo(tt.x), r1 = v0[1] * ((float)((gg.x >> 8) & 255u) * I255) + bfhi(tt.x);
                    const float r2 = v0[2] * ((float)((gg.x >> 16) & 255u) * I255) + bflo(tt.y), r3 = v0[3] * ((float)(gg.x >> 24) * I255) + bfhi(tt.y);
                    const float r4 = v1[0] * ((float)(gg.y & 255u) * I255) + bflo(tt.z), r5 = v1[1] * ((float)((gg.y >> 8) & 255u) * I255) + bfhi(tt.z);
                    const float r6 = v1[2] * ((float)((gg.y >> 16) & 255u) * I255) + bflo(tt.w), r7 = v1[3] * ((float)(gg.y >> 24) * I255) + bfhi(tt.w);
                    if (G3_F8 && u.sub) { u32x2 w8; w8.x = pk4_fp8(r0, r1, r2, r3); w8.y = pk4_fp8(r4, r5, r6, r7); *(u32x2*)(m8 + off) = w8; }
                    else { u32x4 w; w.x = cvt_pk_bf16(r0, r1); w.y = cvt_pk_bf16(r2, r3); w.z = cvt_pk_bf16(r4, r5); w.w = cvt_pk_bf16(r6, r7);
                    *(u32x4*)(mg + off) = w; } }
            asm volatile("" ::: "memory");
        }
    }
};
struct EpiG3 {
    static constexpr bool PERM = true, AFTER_DRAIN = false;
    unsigned char* ws; const float* modl; float scale;
    __device__ __forceinline__ void operator()(const f32x4 (&acc)[2][2][4][2], const Unit& u, int wr, int wc, int fr, int fq) const {
        const int b = u.pm / TPB, jt = u.pm % TPB;
        bf16_t* xt = xb_row(ws, u.pm * 256);
        const float* gt = modl + (size_t)(jt == 0 ? 8 : b) * MODW + 2 * DM;
        const int col0 = u.pn * 256 + wc * 32 + 8 * fq, lrow0 = wr * 64 + fr;
        f32x4 gv[2][2];
#pragma unroll
        for (int bj = 0; bj < 2; ++bj)
#pragma unroll
            for (int n = 0; n < 2; ++n) gv[bj][n] = *(const f32x4*)(gt + col0 + bj * 128 + n * 4) * scale;
#pragma unroll
        for (int ai = 0; ai < 2; ++ai) {
            u32x4 xv[4][2];
#pragma unroll
            for (int m = 0; m < 4; ++m)
#pragma unroll
                for (int bj = 0; bj < 2; ++bj) xv[m][bj] = *(const u32x4*)(xt + (size_t)(lrow0 + ai * 128 + m * 16) * DM + col0 + bj * 128);
#pragma unroll
            for (int m = 0; m < 4; ++m)
#pragma unroll
                for (int bj = 0; bj < 2; ++bj) { const u32x4 x = xv[m][bj]; const f32x4 a0 = gv[bj][0] * acc[ai][bj][m][0], a1 = gv[bj][1] * acc[ai][bj][m][1];
                    u32x4 w; w.x = cvt_pk_bf16(bflo(x.x) + a0[0], bfhi(x.x) + a0[1]); w.y = cvt_pk_bf16(bflo(x.y) + a0[2], bfhi(x.y) + a0[3]);
                    w.z = cvt_pk_bf16(bflo(x.z) + a1[0], bfhi(x.z) + a1[1]); w.w = cvt_pk_bf16(bflo(x.w) + a1[2], bfhi(x.w) + a1[3]);
                    *(u32x4*)(xt + (size_t)(lrow0 + ai * 128 + m * 16) * DM + col0 + bj * 128) = w; }
            asm volatile("" ::: "memory");
        }
    }
};
constexpr float WSC = 1.f / 32.f;
struct EpiE1 {
    static constexpr bool PERM = true, AFTER_DRAIN = false;
    unsigned char* act;
    __device__ __forceinline__ void operator()(const f32x4 (&acc)[2][2][4][2], const Unit& u, int wr, int wc, int fr, int fq) const {
        const int col0 = u.pn * 128 + wc * 32 + 8 * fq; const size_t row0 = (size_t)u.pm * 256 + wr * 64 + fr;
#pragma unroll
        for (int ai = 0; ai < 2; ++ai)
#pragma unroll
            for (int m = 0; m < 4; ++m) {
                const f32x4 a0 = acc[ai][0][m][0], a1 = acc[ai][0][m][1], b0 = acc[ai][1][m][0], b1 = acc[ai][1][m][1];
                float r[8];
#pragma unroll
                for (int t = 0; t < 4; ++t) { const float x0 = a0[t] * WSC, x1 = a1[t] * WSC; r[t] = x0 * fast_sigmoid(x0) * (b0[t] * WSC); r[4 + t] = x1 * fast_sigmoid(x1) * (b1[t] * WSC); }
                u32x2 w; w.x = pk4_fp8(r[0], r[1], r[2], r[3]); w.y = pk4_fp8(r[4], r[5], r[6], r[7]);
                *(u32x2*)(act + (row0 + ai * 128 + m * 16) * DM + col0) = w;
            }
    }
};
constexpr float YSC = 8.f;
struct EpiE2 {
    static constexpr bool PERM = true, AFTER_DRAIN = false;
    unsigned char* y; int nostore;
    __device__ __forceinline__ void operator()(const f32x4 (&acc)[2][2][4][2], const Unit& u, int wr, int wc, int fr, int fq) const {
        const int col0 = u.pn * 256 + wc * 32 + 8 * fq; const size_t row0 = (size_t)u.pm * 256 + wr * 64 + fr;
#pragma unroll
        for (int ai = 0; ai < 2; ++ai)
#pragma unroll
            for (int m = 0; m < 4; ++m)
#pragma unroll
                for (int bj = 0; bj < 2; ++bj) {
                    const f32x4 v0 = acc[ai][bj][m][0] * (WSC * YSC), v1 = acc[ai][bj][m][1] * (WSC * YSC);
                    u32x2 w; w.x = pk4_fp8(v0[0], v0[1], v0[2], v0[3]); w.y = pk4_fp8(v1[0], v1[1], v1[2], v1[3]);
                    if (!nostore) *(u32x2*)(y + (row0 + ai * 128 + m * 16) * DM + col0 + bj * 128) = w; else asm volatile("" :: "v"(w));
                }
    }
};
struct OrderG2 { int G, c; bool noctx; int sub; bool f8;
    __device__ __forceinline__ bool next(int i, Unit& u) const { const int L = i * G + c; if (L >= (noctx ? NB * 16 : NTILE) * 4) return false;
        const int t = L >> 2; u.pm = noctx ? (t >> 4) * TPB + 1 + (t & 15) : t; u.pn = L & 3; u.sub = sub;
        if (f8) { u.pa = (sub ? 3 : 4) * (2 * NTILE) + u.pm; u.pb = sub * 8 + u.pn; }
        else { u.pa = (sub ? 3 : 4) * NTILE + u.pm; u.pb = sub * 4 + u.pn; } return true; }
    __device__ __forceinline__ void a_ready(const Unit&) const {}
    __device__ __forceinline__ void done(const Unit&) const {}
};
struct OrderG1 { int G, c, np; unsigned plist; bool f8;
    __device__ __forceinline__ bool next(int i, Unit& u) const { using namespace pg8;
        const int nN = 4 * np, nwg = NTILE * nN, L = i * G + c; if (L >= nwg) return false;
        int wgid = L; { const int q = nwg / NXCD, r = nwg % NXCD, xcd = wgid % NXCD, off = wgid / NXCD; wgid = (xcd < r ? xcd * (q + 1) : r * (q + 1) + (xcd - r) * q) + off; }
        const int nig = WGM * nN, gid = wgid / nig, fm = gid * WGM, gsz = (NTILE - fm) < WGM ? (NTILE - fm) : WGM;
        u.pm = fm + ((wgid % nig) % gsz); const int ps = (wgid % nig) / gsz, part = (plist >> (4 * (ps >> 2))) & 15;
        u.pn = part * 4 + (ps & 3); u.pa = u.pm; u.pb = f8 ? part * 8 + (ps & 3) : u.pn; u.sub = 0; return true; }
    __device__ __forceinline__ void a_ready(const Unit&) const {}
    __device__ __forceinline__ void done(const Unit&) const {}
};
constexpr int g1_np(unsigned m) { int n = 0; for (int p = 0; p < 7; ++p) n += (m >> p) & 1; return n; }
constexpr unsigned g1_plist(unsigned m) { unsigned l = 0; int n = 0; for (int p = 0; p < 7; ++p) if ((m >> p) & 1) { l |= (unsigned)p << (4 * n); ++n; } return l; }
struct OrderG3 { int G, c; bool noctx;
    __device__ __forceinline__ bool next(int i, Unit& u) const { const int L = i * G + c; if (L >= (noctx ? NB * 16 : NTILE) * 4) return false;
        const int t = L >> 2; u.pm = noctx ? (t >> 4) * TPB + 1 + (t & 15) : t; u.pn = L & 3; u.sub = 0; u.pa = u.pm; u.pb = u.pn; return true; }
    __device__ __forceinline__ void a_ready(const Unit&) const {}
    __device__ __forceinline__ void done(const Unit&) const {}
};
struct OrderE { int G, c, nblk, ng; const LAS int* tab; int a_t0, b_t0;
    __device__ __forceinline__ bool next(int i, Unit& u) const { const int L = i * G + c; if (L >= nblk * ng) return false;
        const int blk = L / ng, g = L - blk * ng, e = __builtin_amdgcn_readfirstlane(tab[blk]);
        u.pm = blk; u.pn = g; u.sub = 0; u.pa = a_t0 + blk; u.pb = b_t0 + e * ng + g; return true; }
    __device__ __forceinline__ void a_ready(const Unit&) const {}
    __device__ __forceinline__ void done(const Unit&) const {}
};

#define XB_TMO      128
#define XB_XCNT(j)  (256  + 64 * (j))
#define XB_XSUB(j)  (1280 + 64 * (j))
#define XB_XGEN(j)  (2304 + 64 * (j))
#define XB_TOP      3328
#define XB_TOPGEN   3392
#define XCD_BAR_WORDS 3456
#define XB_SPIN_CAP (1u << 18)

__device__ __forceinline__ unsigned xb_ld(unsigned* p)              { return __hip_atomic_load(p, __ATOMIC_RELAXED, __HIP_MEMORY_SCOPE_AGENT); }
__device__ __forceinline__ unsigned xb_add(unsigned* p, unsigned v) { return __hip_atomic_fetch_add(p, v, __ATOMIC_RELAXED, __HIP_MEMORY_SCOPE_AGENT); }
__device__ __forceinline__ unsigned xb_xcc_id() { return (unsigned)__builtin_amdgcn_s_getreg((3 << 11) | 20) & 0xFu; }
#define XB_SPIN(cond, bar) do { unsigned _sp = 0; while (cond) { __builtin_amdgcn_s_sleep(1); \
    if ((++_sp & 255u) == 0u) { if (xb_ld(&(bar)[XB_TMO])) break; if (_sp > XB_SPIN_CAP) { atomicAdd(&(bar)[XB_TMO], 1u); break; } } } } while (0)

struct XcdBarrier {
    unsigned* bar; unsigned x;
    volatile LAS unsigned* st;
};
__device__ __forceinline__ XcdBarrier xcd_barrier_post(unsigned* bar, volatile LAS unsigned* st) {
    XcdBarrier b; b.bar = bar; b.x = xb_xcc_id(); b.st = st;
    if (threadIdx.x == 0) (void)xb_add(&bar[XB_XCNT(b.x)], 1u);
    return b;
}
__device__ __forceinline__ void xcd_barrier_complete(unsigned* bar, unsigned x, unsigned& nloc, unsigned& nx) {
    const unsigned G = gridDim.x * gridDim.y * gridDim.z;
    unsigned sum, cnt, mine, sp = 0u;
    for (;;) {
        sum = 0u; cnt = 0u; mine = 0u;
#pragma unroll
        for (unsigned j = 0; j < 16; ++j) { const unsigned c = xb_ld(&bar[XB_XCNT(j)]); sum += c; cnt += (c > 0u) ? 1u : 0u; mine = (j == x) ? c : mine; }
        if (sum == G) break;
        __builtin_amdgcn_s_sleep(1);
        if ((++sp & 255u) == 0u) { if (xb_ld(&bar[XB_TMO])) break; if (sp > XB_SPIN_CAP) { atomicAdd(&bar[XB_TMO], 1u); break; } }
    }
    nloc = mine > 0u ? mine : 1u; nx = cnt > 0u ? cnt : 1u;
}
__device__ __forceinline__ void xcd_barrier(const XcdBarrier& b) {
    asm volatile("s_waitcnt vmcnt(0)" ::: "memory");
    __syncthreads();
    if (threadIdx.x == 0) {
        unsigned* bar = b.bar;
        __builtin_amdgcn_s_waitcnt(0);
        unsigned nloc = b.st[0], nx = b.st[1];
        if (nloc == 0u) { xcd_barrier_complete(bar, b.x, nloc, nx); b.st[0] = nloc; b.st[1] = nx; }
        const unsigned old = xb_add(&bar[XB_XSUB(b.x)], 1u);
        const unsigned gen = old / nloc;
        if (old + 1u == (gen + 1u) * nloc) {
            __builtin_amdgcn_fence(__ATOMIC_RELEASE, "agent");
            asm volatile("s_waitcnt vmcnt(0)" ::: "memory");
            const unsigned og = xb_add(&bar[XB_TOP], 1u);
            const unsigned tg = og / nx;
            if (og + 1u == (tg + 1u) * nx) xb_add(&bar[XB_TOPGEN], 1u);
            else XB_SPIN(xb_ld(&bar[XB_TOPGEN]) == tg, bar);
            __builtin_amdgcn_fence(__ATOMIC_ACQUIRE, "agent");
            xb_add(&bar[XB_XGEN(b.x)], 1u);
            asm volatile("s_waitcnt vmcnt(0)" ::: "memory");
        } else {
            XB_SPIN(xb_ld(&bar[XB_XGEN(b.x)]) == gen, bar);
            __builtin_amdgcn_fence(__ATOMIC_ACQUIRE, "agent");
            asm volatile("s_waitcnt vmcnt(0)" ::: "memory");
        }
    }
    __syncthreads();
}

struct Args { const float* in[27]; float* out; unsigned char* ws; int ph_lo, ph_hi; };
typedef const __attribute__((address_space(4))) Args* KArgs;
__device__ __forceinline__ KArgs kargs() { KArgs p = (KArgs)__builtin_amdgcn_kernarg_segment_ptr(); asm volatile("" : "+s"(p)); return p; }
struct Frame {
    LAS unsigned char* lds; unsigned char* ldsg;
    volatile LAS unsigned* MISC;
    unsigned* ctl; unsigned char* ws; float* out;
    int tid, lane, wave, vcu, G;
};
enum { I_X = 0, I_C, I_CTX, I_CCTX, I_WMOD, I_BMOD, I_GN1, I_GN2, I_WIN, I_CONVW, I_CONVB, I_LWA, I_LBA, I_LWX, I_LBX, I_LLAM, I_DLAM, I_GSUB, I_WRNN, I_WATT, I_WO, I_WROUT, I_BROUT, I_WE1, I_WE3, I_WE2, I_GFIN };

struct TrRegs { f32x4 v[8]; };
__device__ __forceinline__ void tr_load(TrRegs& t, const float* W, int N, int k0, int n0, int lane) {
#pragma unroll
    for (int i = 0; i < 8; ++i) t.v[i] = __builtin_nontemporal_load((const f32x4*)(W + (size_t)(k0 + 8 * i + (lane >> 3)) * N + n0 + 4 * (lane & 7)));
}
template <bool F8> __device__ __forceinline__ void tr_store(const TrRegs& t, int K, int k0, void* WTrow0, LAS float* scr, int lane) {
    constexpr float sc = F8 ? 32.f : 1.f;
#pragma unroll
    for (int i = 0; i < 8; ++i) { LAS float* d = scr + (8 * i + (lane >> 3)) * 33 + 4 * (lane & 7); d[0] = t.v[i][0] * sc; d[1] = t.v[i][1] * sc; d[2] = t.v[i][2] * sc; d[3] = t.v[i][3] * sc; }
    LDS_WAIT(); asm volatile("" ::: "memory");
    const int c = lane & 7;
#pragma unroll
    for (int j = 0; j < 4; ++j) { const int n = (lane >> 3) + 8 * j; const LAS float* s = scr + (8 * c) * 33 + n;
        if constexpr (F8) { u32x2 o; o.x = pk4_fp8(s[0 * 33], s[1 * 33], s[2 * 33], s[3 * 33]); o.y = pk4_fp8(s[4 * 33], s[5 * 33], s[6 * 33], s[7 * 33]);
            *(u32x2*)((unsigned char*)WTrow0 + (size_t)n * K + k0 + 8 * c) = o; }
        else { u32x4 o; o.x = pk2(s[0 * 33], s[1 * 33]); o.y = pk2(s[2 * 33], s[3 * 33]); o.z = pk2(s[4 * 33], s[5 * 33]); o.w = pk2(s[6 * 33], s[7 * 33]);
            *(u32x4*)((bf16_t*)WTrow0 + (size_t)n * K + k0 + 8 * c) = o; } }
    LDS_WAIT(); asm volatile("" ::: "memory");
}
__device__ __forceinline__ void transpose_item(const float* W, int N, int K, int k0, int n0, bf16_t* WTrow0, LAS float* scr, int lane) { TrRegs t; tr_load(t, W, N, k0, n0, lane); tr_store<false>(t, K, k0, WTrow0, scr, lane); }
__device__ __forceinline__ void transpose_item_f8(const float* W, int N, int K, int k0, int n0, unsigned char* WTrow0, LAS float* scr, int lane) { TrRegs t; tr_load(t, W, N, k0, n0, lane); tr_store<true>(t, K, k0, WTrow0, scr, lane); }
constexpr int T_WIN = (DM / 64) * (DIN / 32), T_P = (DM / 64) * (DM / 32), T_LRU = 2 * 8 * 2 * 8, T_LAYER = T_WIN + 3 * T_P + T_LRU;
struct TrGeom { const float* W; int N, K, k0, n0; void* dst; bool f8; };
__device__ __forceinline__ TrGeom mixer_transpose_geom(const Frame& F, KArgs A, int l, int t) {
    unsigned char* wl = F.ws + WS_WMIX + (size_t)l * WMIX_LAYER; TrGeom g;
    if (t < T_WIN) { const int nblk = DIN / 32, kb = t / nblk, nb = t % nblk;
        const int part = nb >> 5;
        g.W = A->in[I_WIN] + (size_t)l * DM * DIN; g.N = DIN; g.K = DM; g.k0 = 64 * kb; g.n0 = 32 * nb; g.f8 = (G1_F8_PARTS >> part) & 1;
        g.dst = g.f8 ? (void*)(wl + WM_WIN + (size_t)part * (2 * MiB) + (size_t)(32 * nb - 1024 * part) * DM) : (void*)((bf16_t*)(wl + WM_WIN) + (size_t)(32 * nb) * DM);
        return g; }
    t -= T_WIN;
    if (t < 3 * T_P) { const int which = t / T_P, tt = t % T_P, nblk = DM / 32, kb = tt / nblk, nb = tt % nblk;
        g.W = A->in[which == 0 ? I_WRNN : (which == 1 ? I_WATT : I_WO)] + (size_t)l * DM * DM; g.N = DM; g.K = DM; g.k0 = 64 * kb; g.n0 = 32 * nb; g.f8 = (which == 1 || (which == 2 && G3_F8));
        g.dst = g.f8 ? (void*)(wl + (which == 1 ? WM_WA : WM_WO) + (size_t)(32 * nb) * DM) : (void*)((bf16_t*)(wl + (which == 0 ? WM_WR : WM_WO)) + (size_t)(32 * nb) * DM);
        return g; }
    t -= 3 * T_P;
    { const int mat = t >> 3, item = t & 7, d = mat >> 4, blk = (mat >> 1) & 7, ax = mat & 1, kb = item >> 2, nb = item & 3;
        g.W = A->in[ax ? I_LWX : I_LWA] + ((size_t)(l * 2 + d) * 8 + blk) * 128 * 128; g.N = 128; g.K = 128; g.k0 = 64 * kb; g.n0 = 32 * nb; g.f8 = false;
        g.dst = (void*)((bf16_t*)(wl + WM_LRU) + ((size_t)(d * 8 + blk) * 256 + ax * 128 + 32 * nb) * 128); }
    return g;
}
__device__ __forceinline__ void mixer_transpose_item(const Frame& F, KArgs A, int l, int t, LAS float* scr, const int lane) {
    const TrGeom g = mixer_transpose_geom(F, A, l, t); TrRegs r; tr_load(r, g.W, g.N, g.k0, g.n0, lane);
    if (g.f8) tr_store<true>(r, g.K, g.k0, g.dst, scr, lane); else tr_store<false>(r, g.K, g.k0, g.dst, scr, lane);
}
__device__ __forceinline__ void mixer_conv_unit(const Frame& F0, KArgs, int cu) {
    KArgs A = kargs(); Frame F = F0; F.ws = A->ws;
    LAS float* scr = (LAS float*)(F.lds + F.wave * 8704);
    int ln = F.lane; asm volatile("" : "+v"(ln));
    for (int j = 0; j < 6; ++j) mixer_transpose_item(F, A, 1, cu * 48 + F.wave * 6 + j, scr, ln);
    __syncthreads();
}
__device__ __forceinline__ void p0_phase(const Frame& F, KArgs A, int skip = 0) {
    LAS float* sil = (LAS float*)(F.lds + 73728);
    for (int i = F.tid; i < NCOND * DM; i += NWAVES * 64) { const int r = i >> 10, k = i & 1023; const float c = r < 8 ? A->in[I_C][r * DM + k] : A->in[I_CCTX][k]; sil[i] = c / (1.f + expf(-c)); }
    __syncthreads();
    const int gw = F.vcu * NWAVES + F.wave, NGW = F.G * NWAVES, lane = F.lane;
    constexpr int N_ADA = NLAYER * (MODW / 64);
    if (skip != 1) {   LAS float* red = (LAS float*)(F.lds + 112640);
        for (int it = F.vcu; it < N_ADA; it += F.G) {
            const int l = it / (MODW / 64), col = (it % (MODW / 64)) * 64 + lane;
            const float* w = A->in[I_WMOD] + ((size_t)l * DM + F.wave * 128) * MODW + col;
            float acc[NCOND];
#pragma unroll
            for (int q = 0; q < NCOND; ++q) acc[q] = 0.f;
#pragma unroll 16
            for (int k = 0; k < 128; ++k) { const float wv = w[(size_t)k * MODW];
#pragma unroll
                for (int q = 0; q < NCOND; ++q) acc[q] += sil[q * DM + F.wave * 128 + k] * wv; }
#pragma unroll
            for (int q = 0; q < NCOND; ++q) red[(F.wave * NCOND + q) * 64 + lane] = acc[q];
            __syncthreads();
            for (int o = F.tid; o < NCOND * 64; o += NWAVES * 64) { const int q = o >> 6, cl = o & 63; float s = 0.f;
#pragma unroll
                for (int wv = 0; wv < NWAVES; ++wv) s += red[(wv * NCOND + q) * 64 + cl];
                const int cc = (it % (MODW / 64)) * 64 + cl;
                ((float*)(F.ws + WS_MODV))[((size_t)l * NCOND + q) * MODW + cc] = s + A->in[I_BMOD][l * MODW + cc]; }
            __syncthreads();
        }
    }
    LAS float* scr = (LAS float*)(F.lds + F.wave * 8704);
    constexpr int N_TR = NLAYER * T_LAYER, N_ROPE = SEQ * 32 / 64, N_TOT = N_TR + N_ROPE + 1;
    if (skip != 2) {
        static_assert(N_TR <= 6 * 256 * NWAVES, "six items per wave");
        TrRegs tr[2]; if (gw < N_TR) { const TrGeom g = mixer_transpose_geom(F, A, gw / T_LAYER, gw % T_LAYER); tr_load(tr[0], g.W, g.N, g.k0, g.n0, lane); }
#pragma unroll
        for (int j = 0; j < 6; ++j) { const int it = gw + j * NGW, nx = it + NGW;
            if (j + 1 < 6 && nx < N_TR) { const TrGeom g = mixer_transpose_geom(F, A, nx / T_LAYER, nx % T_LAYER); tr_load(tr[(j + 1) & 1], g.W, g.N, g.k0, g.n0, lane); }
            if (it < N_TR) { const TrGeom g = mixer_transpose_geom(F, A, it / T_LAYER, it % T_LAYER);
                if (g.f8) tr_store<true>(tr[j & 1], g.K, g.k0, g.dst, scr, lane); else tr_store<false>(tr[j & 1], g.K, g.k0, g.dst, scr, lane); } }
    }
    for (int it = gw; it < N_TOT; it += NGW) {
        int r = it;
        if (r < N_TR) continue;
        r -= N_TR;
        if (r < N_ROPE) { const int idx = r * 64 + lane, s = idx >> 5, i = idx & 31, j = i & 15;
            const float inv = powf(10000.f, -(float)j / 16.f), pos = (float)(i < 16 ? (s >> 6) : (s & 63)), ang = pos * inv;
            ((float*)(F.ws + WS_COS))[idx] = cosf(ang); ((float*)(F.ws + WS_SIN))[idx] = sinf(ang); continue; }
        {
            float* lams = (float*)(F.ws + WS_LAM);
            for (int l = 0; l < NLAYER; ++l) { const float* dl = A->in[I_DLAM] + l * 256;
                const float s1 = wave_sum(dl[lane] * dl[64 + lane]), s2 = wave_sum(dl[128 + lane] * dl[192 + lane]);
                const float lam_init = 0.8f - 0.6f * expf(-0.3f * (float)l);
                if (lane == 0) { lams[l * 2] = expf(s1) - expf(s2) + lam_init; lams[l * 2 + 1] = 1.f - lam_init; } }
        }
    }
}

__device__ __forceinline__ float* xrow_ptr(const Frame& F, int R, int& cond) {
    const int b = R / PBR, p = R - b * PBR;
    if (p < LC) { cond = 8; return (float*)(F.ws + WS_XC) + ((size_t)b * LC + p) * DM; }
    cond = b; return F.out + ((size_t)b * SEQ + (p - LC)) * DM;
}
struct YRows { unsigned a[4], b[4]; float g1; bool on; };
__device__ __forceinline__ u32x4 tokc_load(const Frame& F, int R) { const unsigned* p = (const unsigned*)((const u32x4*)(F.ws + WS_TOKC) + R); u32x4 t; t.x = ld_dev(p); t.y = ld_dev(p + 1); t.z = ld_dev(p + 2); t.w = ld_dev(p + 3); return t; }
__device__ __forceinline__ void y_load(const Frame& F, const u32x4 t, YRows& y, int R) {
    y.on = t.w != 0u; y.g1 = ld_devf((const float*)(F.ws + WS_TOKGATE) + R);
    const unsigned char* y1 = F.ws + WS_XB + (size_t)(y.on ? t.x : 0u) * DM, *y2 = F.ws + WS_XB + (size_t)(y.on ? t.y : 0u) * DM;
#pragma unroll
    for (int j = 0; j < 4; ++j) { const int c = 256 * j + 4 * F.lane; y.a[j] = *(const unsigned*)(y1 + c); y.b[j] = *(const unsigned*)(y2 + c); }
}
__device__ __forceinline__ void combine_apply(const Frame& F, const YRows& y, int cond, int ylayer, f32x4 (&v)[4]) {
    if (!y.on) return;
    const float g1 = y.g1 * (1.f / YSC), g2 = (1.f - y.g1) * (1.f / YSC);
    const float* gt2 = (const float*)(F.ws + WS_MODV) + ((size_t)ylayer * NCOND + cond) * MODW + 5 * DM;
#pragma unroll
    for (int j = 0; j < 4; ++j) { const int c = 256 * j + 4 * F.lane; const int a = (int)y.a[j], b = (int)y.b[j]; const f32x4 g = *(const f32x4*)(gt2 + c);
        v[j][0] += g[0] * (g1 * __builtin_amdgcn_cvt_f32_fp8(a, 0) + g2 * __builtin_amdgcn_cvt_f32_fp8(b, 0)); v[j][1] += g[1] * (g1 * __builtin_amdgcn_cvt_f32_fp8(a, 1) + g2 * __builtin_amdgcn_cvt_f32_fp8(b, 1));
        v[j][2] += g[2] * (g1 * __builtin_amdgcn_cvt_f32_fp8(a, 2) + g2 * __builtin_amdgcn_cvt_f32_fp8(b, 2)); v[j][3] += g[3] * (g1 * __builtin_amdgcn_cvt_f32_fp8(a, 3) + g2 * __builtin_amdgcn_cvt_f32_fp8(b, 3)); }
}
__device__ __forceinline__ void n1_phase(const Frame& F, KArgs A, int l) {
    const int gw = F.vcu * NWAVES + F.wave, NGW = F.G * NWAVES, lane = F.lane;
    for (int R0 = gw; R0 < TR; R0 += 2 * NGW) {
        f32x4 v[2][4]; bf16_t* xp[2]; int cond[2]; bool ok[2]; YRows y[2];
#pragma unroll
        for (int u = 0; u < 2; ++u) { const int R = R0 + u * NGW; ok[u] = R < TR; const int Rc = ok[u] ? R : R0;
            xp[u] = xb_row(F.ws, Rc); cond[u] = cond_of(Rc);
            if (l == 0) { const int b = Rc / PBR, p = Rc - b * PBR; const float* src = p < LC ? A->in[I_CTX] + ((size_t)b * LC + p) * DM : A->in[I_X] + ((size_t)b * SEQ + (p - LC)) * DM;
#pragma unroll
                for (int j = 0; j < 4; ++j) v[u][j] = __builtin_nontemporal_load((const f32x4*)(src + 256 * j + 4 * lane)); }
            else {
#pragma unroll
                for (int j = 0; j < 4; ++j) v[u][j] = bf4(*(const u32x2*)(xp[u] + 256 * j + 4 * lane)); }
        }
        f32x4 gnv[4], shv[2][4], scv[2][4];
#pragma unroll
        for (int j = 0; j < 4; ++j) { const int c = 256 * j + 4 * lane; gnv[j] = *(const f32x4*)(A->in[I_GN1] + l * DM + c);
#pragma unroll
            for (int u = 0; u < 2; ++u) { const float* md = (const float*)(F.ws + WS_MODV) + ((size_t)l * NCOND + cond[u]) * MODW; shv[u][j] = *(const f32x4*)(md + c); scv[u][j] = *(const f32x4*)(md + DM + c); } }
        if (l > 0) { u32x4 t[2];
#pragma unroll
            for (int u = 0; u < 2; ++u) t[u] = tokc_load(F, ok[u] ? R0 + u * NGW : R0);
#pragma unroll
            for (int u = 0; u < 2; ++u) y_load(F, t[u], y[u], ok[u] ? R0 + u * NGW : R0);
        }
#pragma unroll
        for (int u = 0; u < 2; ++u) { if (!ok[u]) continue; const int R = R0 + u * NGW;
            if (l > 0) combine_apply(F, y[u], cond[u], l - 1, v[u]);
            float ss = 0.f;
#pragma unroll
            for (int j = 0; j < 4; ++j) { u32x2 xw; xw.x = pk2(v[u][j][0], v[u][j][1]); xw.y = pk2(v[u][j][2], v[u][j][3]); *(u32x2*)(xp[u] + 256 * j + 4 * lane) = xw; ss += (v[u][j][0] * v[u][j][0] + v[u][j][1] * v[u][j][1]) + (v[u][j][2] * v[u][j][2] + v[u][j][3] * v[u][j][3]); }
            const float rstd = 1.f / sqrtf(wave_sum(ss) * (1.f / DM) + EPSN);
            unsigned char* hp8 = F.ws + WS_HA8 + (size_t)R * DM; bf16_t* hp = (bf16_t*)(F.ws + WS_HA) + (size_t)R * DM;
#pragma unroll
            for (int j = 0; j < 4; ++j) { const int c = 256 * j + 4 * lane; const f32x4 g = gnv[j], sh = shv[u][j], sc = scv[u][j];
                f32x4 h = (v[u][j] * rstd) * g; h = h * (sc + 1.f) + sh;
                if (G1_F8_PARTS != 0) *(unsigned*)(hp8 + c) = pk4_fp8(h[0], h[1], h[2], h[3]);
                if (G1_F8_PARTS != 0x7f) { u32x2 w; w.x = pk2(h[0], h[1]); w.y = pk2(h[2], h[3]); *(u32x2*)(hp + c) = w; } }
        }
    }
}
__device__ __forceinline__ void final_phase(const Frame& F, KArgs A) {
    const int gw = F.vcu * NWAVES + F.wave, NGW = F.G * NWAVES, lane = F.lane;
    constexpr int NLAT = NB * SEQ;
    for (int T0 = gw; T0 < NLAT; T0 += 2 * NGW) {
        f32x4 v[2][4]; float* xp[2]; int cond[2]; bool ok[2]; YRows y[2]; u32x4 t[2];
#pragma unroll
        for (int u = 0; u < 2; ++u) { const int T = T0 + u * NGW; ok[u] = T < NLAT; const int Tc = ok[u] ? T : T0; const int b = Tc / SEQ; cond[u] = b;
            xp[u] = F.out + (size_t)Tc * DM; const bf16_t* xr = xb_row(F.ws, b * PBR + LC + (Tc - b * SEQ));
#pragma unroll
            for (int j = 0; j < 4; ++j) v[u][j] = bf4(*(const u32x2*)(xr + 256 * j + 4 * lane));
            t[u] = tokc_load(F, b * PBR + LC + (Tc - b * SEQ));
        }
#pragma unroll
        for (int u = 0; u < 2; ++u) { const int T = ok[u] ? T0 + u * NGW : T0; const int b = T / SEQ; y_load(F, t[u], y[u], b * PBR + LC + (T - b * SEQ)); }
#pragma unroll
        for (int u = 0; u < 2; ++u) { if (!ok[u]) continue;
            if (DBG_STOP_AFTER >= N_PHASES - 2) combine_apply(F, y[u], cond[u], NLAYER - 1, v[u]);
            float ss = 0.f;
#pragma unroll
            for (int j = 0; j < 4; ++j) ss += (v[u][j][0] * v[u][j][0] + v[u][j][1] * v[u][j][1]) + (v[u][j][2] * v[u][j][2] + v[u][j][3] * v[u][j][3]);
            const float rstd = 1.f / sqrtf(wave_sum(ss) * (1.f / DM) + EPSN);
#pragma unroll
            for (int j = 0; j < 4; ++j) { const int c = 256 * j + 4 * lane; const f32x4 g = *(const f32x4*)(A->in[I_GFIN] + c); __builtin_nontemporal_store((v[u][j] * rstd) * g, (f32x4*)(xp[u] + c)); }
        }
    }
}
__device__ __forceinline__ void r1_phase(const Frame& F, KArgs A, int l, int pv = 0) {
    LAS f32x4* wr4 = (LAS f32x4*)F.lds;
    LAS unsigned* cw = (LAS unsigned*)(F.lds + 65536);
    LAS unsigned* bs = (LAS unsigned*)(F.lds + 65536 + 512);
    LAS unsigned* rec = (LAS unsigned*)(F.lds + 65536 + 1024);
    for (int idx = F.tid; idx < DM * NEXP; idx += NWAVES * 64) { const int k = idx >> 4, e = idx & 15, j = k >> 8, ln = (k & 255) >> 2, i = k & 3, q = e >> 2, t = e & 3;
        ((LAS float*)F.lds)[((((j * 4 + i) * 4 + q) * 64 + ln) << 2) + t] = A->in[I_WROUT][idx]; }
    if (F.tid < 128) cw[F.tid] = 0u;
    __syncthreads();
    const int lane = F.lane, wave = F.wave;
    constexpr int RPW = TR / 256 / NWAVES;
    const bool last = (l == NLAYER - 1);
    u32x2 vn[4];
    { const bf16_t* x0 = xb_row(F.ws, F.vcu * (TR / 256) + wave * RPW);
#pragma unroll
        for (int j = 0; j < 4; ++j) vn[j] = *(const u32x2*)(x0 + 256 * j + 4 * lane); }
    for (int i = 0; i < RPW; ++i) {
        const int R = F.vcu * (TR / 256) + wave * RPW + i;
        const int b = R / PBR, p = R - b * PBR;
        if (last && p < LC) { if (lane == 0) rec[(wave * RPW + i) * 4] = 255u;
            if (i + 1 < RPW) { const bf16_t* xn = xb_row(F.ws, R + 1);
#pragma unroll
                for (int j = 0; j < 4; ++j) vn[j] = *(const u32x2*)(xn + 256 * j + 4 * lane); }
            continue; }
        const int cond = cond_of(R);
        f32x4 v[4]; float ss = 0.f;
#pragma unroll
        for (int j = 0; j < 4; ++j) { v[j] = bf4(vn[j]); ss += (v[j][0] * v[j][0] + v[j][1] * v[j][1]) + (v[j][2] * v[j][2] + v[j][3] * v[j][3]); }
        if (i + 1 < RPW) { const bf16_t* xn = xb_row(F.ws, R + 1);
#pragma unroll
            for (int j = 0; j < 4; ++j) vn[j] = *(const u32x2*)(xn + 256 * j + 4 * lane); }
        const float rstd = 1.f / sqrtf(wave_sum(ss) * (1.f / DM) + EPSN);
        const float* gn = A->in[I_GN2] + l * DM; const float* md = (const float*)(F.ws + WS_MODV) + ((size_t)l * NCOND + cond) * MODW + 3 * DM;
        unsigned char* hp = F.ws + WS_HA + (size_t)R * DM;
        float lg[NEXP];
#pragma unroll
        for (int e = 0; e < NEXP; ++e) lg[e] = 0.f;
        f32x4 gv4[4], shv4[4], scv4[4];
#pragma unroll
        for (int j = 0; j < 4; ++j) { const int c = 256 * j + 4 * lane; gv4[j] = *(const f32x4*)(gn + c); shv4[j] = *(const f32x4*)(md + c); scv4[j] = *(const f32x4*)(md + DM + c); }
#pragma unroll
        for (int j = 0; j < 4; ++j) { const int c = 256 * j + 4 * lane; const f32x4 g = gv4[j], sh = shv4[j], sc = scv4[j];
            f32x4 h = (v[j] * rstd) * g; h = h * (sc + 1.f) + sh;
            *(unsigned*)(hp + c) = pk4_fp8(h[0], h[1], h[2], h[3]);
            if (pv != 1)
#pragma unroll
            for (int ii = 0; ii < 4; ++ii)
#pragma unroll
                for (int q = 0; q < 4; ++q) { const f32x4 w4 = R1_GLOBAL_W ? *(const f32x4*)(A->in[I_WROUT] + (size_t)(c + ii) * NEXP + 4 * q) : wr4[((j * 4 + ii) * 4 + q) * 64 + lane];
                    lg[4 * q + 0] += h[ii] * w4[0]; lg[4 * q + 1] += h[ii] * w4[1]; lg[4 * q + 2] += h[ii] * w4[2]; lg[4 * q + 3] += h[ii] * w4[3]; } }
#pragma unroll
        for (int e = 0; e < NEXP; ++e) lg[e] = (pv == 2 ? lg[e] : wave_sum(lg[e])) + A->in[I_BROUT][e];
        int best = 0; float bv = lg[0];
#pragma unroll
        for (int e = 1; e < NEXP; ++e) if (lg[e] > bv) { bv = lg[e]; best = e; }
        const int grp = best >> 2; int e2 = -1; float v2 = 0.f;
#pragma unroll
        for (int e = 0; e < NEXP; ++e) if ((e >> 2) == grp && e != best && (e2 < 0 || lg[e] > v2)) { v2 = lg[e]; e2 = e; }
        const float g1 = __builtin_amdgcn_rcpf(1.f + __builtin_amdgcn_exp2f(-1.4426950408889634f * fabsf(bv - v2)));
        const unsigned r1 = cw[wave * 16 + best], r2 = cw[wave * 16 + e2];
        LDS_WAIT(); asm volatile("" ::: "memory");
        if (lane == 0) { cw[wave * 16 + best] = r1 + 1u; cw[wave * 16 + e2] = r2 + 1u;
            LAS unsigned* rr = rec + (wave * RPW + i) * 4; rr[0] = (unsigned)best | ((unsigned)e2 << 8); rr[1] = r1; rr[2] = r2; rr[3] = 0u;
            ((float*)(F.ws + WS_TOKGATE))[R] = g1; }
        LDS_WAIT(); asm volatile("" ::: "memory");
    }
    __syncthreads();
    if (F.tid < NEXP) { unsigned run = 0u; for (int w = 0; w < NWAVES; ++w) { bs[w * 16 + F.tid] = run; run += cw[w * 16 + F.tid]; }
        ((unsigned*)(F.ws + WS_CNT))[F.vcu * 16 + F.tid] = run; }
    __syncthreads();
    if (lane < RPW) { const LAS unsigned* rr = rec + (wave * RPW + lane) * 4; const int R = F.vcu * (TR / 256) + wave * RPW + lane;
        u32x4 o; o.x = rr[0];
        if ((o.x & 255u) == 255u) { o.y = 0u; o.z = 0u; o.w = 0u; }
        else { o.y = rr[1] + bs[wave * 16 + (o.x & 255u)]; o.z = rr[2] + bs[wave * 16 + ((o.x >> 8) & 255u)]; o.w = rr[3]; }
        ((u32x4*)(F.ws + WS_TOKINFO))[R] = o; }
    __syncthreads();
}
__device__ __forceinline__ void r2_phase(const Frame& F, KArgs A, int l) {
    LAS unsigned* cn = (LAS unsigned*)F.lds;
    LAS unsigned* pst = (LAS unsigned*)(F.lds + 16384);
    LAS int* tab = (LAS int*)(F.lds + 16384 + 256);
    for (int i = F.tid; i < 256 * 16; i += NWAVES * 64) cn[i] = ((const unsigned*)(F.ws + WS_CNT))[i];
    __syncthreads();
    if (F.tid < NEXP) { unsigned tot = 0u, pre = 0u; for (int w = 0; w < 256; ++w) { const unsigned c = cn[w * 16 + F.tid]; if (w < F.vcu) pre += c; tot += c; }
        pst[32 + F.tid] = tot; pst[16 + F.tid] = pre; }
    __syncthreads();
    if (F.tid == 0) { unsigned run = 0u; for (int e = 0; e < NEXP; ++e) { const unsigned pad = (pst[32 + e] + 255u) & ~255u; pst[e] = run + pst[16 + e];
            for (unsigned bk = run >> 8; bk < ((run + pad) >> 8); ++bk) tab[bk] = e; run += pad; }
        tab[300] = (int)(run >> 8); }
    __syncthreads();
    if (F.vcu == 0) { for (int i = F.tid; i < 320; i += NWAVES * 64) ((int*)(F.ws + WS_BLKTAB))[i] = (i < MAXBLK || i == 300) ? tab[i] : 0; }
    const int lane = F.lane, wave = F.wave;
    constexpr int RPW = TR / 256 / NWAVES;
    const int R0 = F.vcu * (TR / 256) + wave * RPW;
    unsigned s1 = 0u, s2 = 0u, on = 0u;
    if (lane < RPW) { const int R = R0 + lane; const unsigned* ip = (const unsigned*)((const u32x4*)(F.ws + WS_TOKINFO) + R);
        const unsigned ix = ld_dev(ip), iy = ld_dev(ip + 1), iz = ld_dev(ip + 2); const unsigned gt = ld_dev((const float*)(F.ws + WS_TOKGATE) + R);
        on = ((ix & 255u) != 255u) ? 1u : 0u;
        if (on) { s1 = pst[ix & 255u] + iy; s2 = pst[(ix >> 8) & 255u] + iz; }
        u32x4 tc; tc.x = s1; tc.y = s2; tc.z = on ? gt : 0u; tc.w = on; ((u32x4*)(F.ws + WS_TOKC))[R] = tc; }
#pragma unroll
    for (int i0 = 0; i0 < RPW; i0 += 6) {
        u32x4 a[6];
#pragma unroll
        for (int k = 0; k < 6; ++k) if (i0 + k < RPW) a[k] = ((const u32x4*)(F.ws + WS_HA + (size_t)(R0 + i0 + k) * DM))[lane];
#pragma unroll
        for (int k = 0; k < 6; ++k) if (i0 + k < RPW) {
            const unsigned o1 = __builtin_amdgcn_readlane(s1, i0 + k), o2 = __builtin_amdgcn_readlane(s2, i0 + k), v = __builtin_amdgcn_readlane(on, i0 + k);
            if (v) { ((u32x4*)(F.ws + WS_XB + (size_t)o1 * DM))[lane] = a[k]; ((u32x4*)(F.ws + WS_XB + (size_t)o2 * DM))[lane] = a[k]; } }
    }
}
__device__ __forceinline__ void expert_conv_unit(const Frame& F, KArgs A, int l, int cu) {
    LAS float* scr = (LAS float*)(F.lds + F.wave * 8704);
    int ln = F.lane; asm volatile("" : "+v"(ln));
    constexpr int T_M = (DM / 64) * (DM / 32);
#define EC_GEOM(j) const int it = cu * 48 + F.wave * 6 + (j); const int mat = it / T_M, t = it % T_M, e = mat / 3, which = mat % 3, kb = t / 32, nb = t % 32, n0 = 32 * nb; \
        const float* W = A->in[which == 0 ? I_WE1 : (which == 1 ? I_WE3 : I_WE2)] + ((size_t)l * NEXP + e) * DM * DM
    TrRegs tr[2];
    { EC_GEOM(0); tr_load(tr[0], W, DM, 64 * kb, n0, ln); }
#pragma unroll
    for (int j = 0; j < 6; ++j) {
        if (j + 1 < 6) { EC_GEOM(j + 1); tr_load(tr[(j + 1) & 1], W, DM, 64 * kb, n0, ln); }
        EC_GEOM(j);
        unsigned char* dst = which == 2 ? F.ws + WS_W2 + ((size_t)e * DM + n0) * DM
                                        : F.ws + WS_W13 + ((size_t)e * 2048 + (size_t)(n0 >> 7) * 256 + which * 128 + (n0 & 127)) * DM;
        tr_store<true>(tr[j & 1], DM, 64 * kb, dst, scr, ln);
    }
#undef EC_GEOM
    __syncthreads();
}

namespace att {
constexpr float SCALE = 0.125f;
constexpr float TOP = 5.f, SLACK = 3.5f;
constexpr int SHM_V = 64 * 128 * 2, SHM_K = 64 * 128 * 2;
typedef int i32x4 __attribute__((ext_vector_type(4)));
typedef int i32x8 __attribute__((ext_vector_type(8)));
#define KSWZ(row, colB) ((row) * 256 + ((colB) ^ (((row) & 7) << 4)))
__device__ __forceinline__ int crow(int r, int hi) { return (r & 3) + 8 * (r >> 2) + 4 * hi; }
__device__ __forceinline__ void set_mneg(f32x16& mneg, const float nm) { asm volatile("v_mov_b32 %0, %16\n\tv_mov_b32 %1, %16\n\tv_mov_b32 %2, %16\n\tv_mov_b32 %3, %16\n\tv_mov_b32 %4, %16\n\tv_mov_b32 %5, %16\n\tv_mov_b32 %6, %16\n\tv_mov_b32 %7, %16\n\tv_mov_b32 %8, %16\n\tv_mov_b32 %9, %16\n\tv_mov_b32 %10, %16\n\tv_mov_b32 %11, %16\n\tv_mov_b32 %12, %16\n\tv_mov_b32 %13, %16\n\tv_mov_b32 %14, %16\n\tv_mov_b32 %15, %16"
        : "+v"(mneg[0]), "+v"(mneg[1]), "+v"(mneg[2]), "+v"(mneg[3]), "+v"(mneg[4]), "+v"(mneg[5]), "+v"(mneg[6]), "+v"(mneg[7]), "+v"(mneg[8]), "+v"(mneg[9]), "+v"(mneg[10]), "+v"(mneg[11]), "+v"(mneg[12]), "+v"(mneg[13]), "+v"(mneg[14]), "+v"(mneg[15]) : "v"(nm)); }
__device__ __forceinline__ void partialSM_nb(f32x16& p0, f32x16& p1, float& m_reg, f32x16& mneg, float& alpha, int dryv = 0) {
  alpha = 1.f;
  if (dryv != 2 && dryv != 9) { for (int r = 0; r < 16; ++r) p0[r] = __builtin_amdgcn_exp2f(p0[r]); for (int r = 0; r < 16; ++r) p1[r] = __builtin_amdgcn_exp2f(p1[r]); }
  float m0 = p0[0], m1 = p1[0]; if (dryv != 5 && dryv != 9) { for (int r = 1; r < 16; ++r) m0 = fmaxf(m0, p0[r]); for (int r = 1; r < 16; ++r) m1 = fmaxf(m1, p1[r]); }
  constexpr float LIMLIN = 362.03867f;
  static_assert(TOP + SLACK == 8.5f, "LIMLIN = 2^(TOP + SLACK)");
  m0 = fmaxf(m0, m1);
  if (!__builtin_expect(__all(m0 <= LIMLIN), 1)) {
    float pmax = __builtin_amdgcn_logf(m0);
    { auto rr = __builtin_amdgcn_permlane32_swap(__float_as_uint(pmax), __float_as_uint(pmax), false, false);
      pmax = fmaxf(__uint_as_float(rr[0]), __uint_as_float(rr[1])); }
    const float d = fmaxf(pmax - TOP, 0.f); alpha = __builtin_amdgcn_exp2f(-d); m_reg += d;
    for (int r = 0; r < 16; ++r) p0[r] *= alpha; for (int r = 0; r < 16; ++r) p1[r] *= alpha; set_mneg(mneg, -m_reg); }
}
__device__ __forceinline__ void partialSM(f32x16& p0, f32x16& p1, float& m_reg, f32x16& mneg, float& alpha, bool first, int dryv = 0) {
  alpha = 1.f;
  float pmax = p0[0]; if (dryv != 5 && dryv != 9) { for (int r = 1; r < 16; ++r) pmax = fmaxf(pmax, p0[r]); for (int r = 0; r < 16; ++r) pmax = fmaxf(pmax, p1[r]); }
  { auto rr = __builtin_amdgcn_permlane32_swap(__float_as_uint(pmax), __float_as_uint(pmax), false, false);
    pmax = fmaxf(__uint_as_float(rr[0]), __uint_as_float(rr[1])); }
  if (first || !__builtin_expect(__all(pmax <= TOP + SLACK), 1)) { const float d = first ? pmax - TOP : fmaxf(pmax - TOP, 0.f); alpha = __builtin_amdgcn_exp2f(-d); m_reg += d;
    for (int r = 0; r < 16; ++r) p0[r] -= d; for (int r = 0; r < 16; ++r) p1[r] -= d; set_mneg(mneg, -m_reg); }
  if (dryv != 2 && dryv != 9) for (int r = 0; r < 16; ++r) p0[r] = __builtin_amdgcn_exp2f(p0[r]);
}
__device__ __forceinline__ void finishSM(f32x16& p0, f32x16& p1, i32x8& pa, int dryv = 0, bool exp1 = false) {
  if (exp1) for (int r = 0; r < 16; ++r) p1[r] = __builtin_amdgcn_exp2f(p1[r]);
#pragma unroll
  for (int t = 0; t < 8; ++t) { int w; asm volatile("" : "=v"(w)); w = __builtin_amdgcn_cvt_pk_fp8_f32(p0[t], p0[t + 8], w, false); pa[t] = __builtin_amdgcn_cvt_pk_fp8_f32(p1[t], p1[t + 8], w, true); }
}
#define KSWZ8(row, colB) ((row) * 128 + ((colB) ^ ((((row) >> 1) & 7) << 4)))
__device__ __forceinline__ void qkt(f32x16& p0, f32x16& p1, const char* Ks, const i32x8 qr, int r32, int hi, int csub, const f32x16& mneg) {
  const int cb = csub * 64 + hi * 32;
  const i32x4 a0 = *reinterpret_cast<const i32x4*>(Ks + KSWZ8(r32, cb)), a1 = *reinterpret_cast<const i32x4*>(Ks + KSWZ8(r32, cb + 16));
  const i32x4 b0 = *reinterpret_cast<const i32x4*>(Ks + KSWZ8(32 + r32, cb)), b1 = *reinterpret_cast<const i32x4*>(Ks + KSWZ8(32 + r32, cb + 16));
  p0 = __builtin_amdgcn_mfma_scale_f32_32x32x64_f8f6f4(__builtin_shufflevector(a0, a1, 0, 1, 2, 3, 4, 5, 6, 7), qr, mneg, 0, 0, 0, 0, 0, 0);
  p1 = __builtin_amdgcn_mfma_scale_f32_32x32x64_f8f6f4(__builtin_shufflevector(b0, b1, 0, 1, 2, 3, 4, 5, 6, 7), qr, mneg, 0, 0, 0, 0, 0, 0);
}
struct VRegs { i32x4 lo[4], hh[4]; };
template <int H> __device__ __forceinline__ void pv_load(VRegs& v, const char* Vs, int voff) {
#pragma unroll
  for (int d0 = 2 * H; d0 < 2 * H + 2; ++d0) { v.lo[d0] = *reinterpret_cast<const i32x4*>(Vs + d0 * 2048 + voff); v.hh[d0] = *reinterpret_cast<const i32x4*>(Vs + d0 * 2048 + (voff ^ 16)); }
}
__device__ __forceinline__ void pv_mma(f32x16* o, f32x16& lacc, const i32x8 ones, const VRegs& v, i32x8 pa) {
#pragma unroll
  for (int d0 = 0; d0 < 4; ++d0) { const i32x8 vv = __builtin_shufflevector(v.lo[d0], v.hh[d0], 0, 1, 2, 3, 4, 5, 6, 7);
    o[d0] = __builtin_amdgcn_mfma_scale_f32_32x32x64_f8f6f4(pa, vv, o[d0], 0, 0, 0, 0, 0, 0); }
  lacc = __builtin_amdgcn_mfma_scale_f32_32x32x64_f8f6f4(pa, ones, lacc, 0, 0, 0, 0, 0, 0);
}
__device__ __forceinline__ void attn_unit(const unsigned char* __restrict__ Qb, const unsigned char* __restrict__ Kh, const unsigned char* __restrict__ VTh, unsigned char* Ob,
                                          int seq, float lam, float oscale, const float* __restrict__ gsub, char* lds, LAS unsigned char* ldsl, int tid, bool dry = false) {
  asm volatile("" : "+v"(tid));
  const int wid = __builtin_amdgcn_readfirstlane(tid >> 6), lane = tid & 63, r32 = lane & 31, hi = lane >> 5, csub = wid >> 2, wq = wid & 3;
  constexpr int STG = 16384, VOFF = 8192;
  float* ws = (float*)(lds + 4 * STG) + wid * 64; float* al_l = ws + 32;
  float m_reg = 0.f; f32x16 o[4] = {}, lacc = {}, mneg = {}; i32x8 qr, ones; { int o1 = 0x38383838; asm volatile("" : "+v"(o1)); ones = (i32x8){o1, o1, o1, o1, o1, o1, o1, o1}; }
  { const unsigned char* Qw = Qb + (size_t)(wq * 32 + r32) * DM + csub * 64 + hi * 32;
    const i32x4 q0 = *reinterpret_cast<const i32x4*>(Qw), q1 = *reinterpret_cast<const i32x4*>(Qw + 16); qr = __builtin_shufflevector(q0, q1, 0, 1, 2, 3, 4, 5, 6, 7); }
  const unsigned kofs = (unsigned)((tid >> 3) * DM + (((tid & 7) ^ ((tid >> 4) & 7)) << 4));
  const unsigned vofs = (unsigned)((tid >> 2) * (68 * 64) + (((tid & 3) ^ ((tid >> 4) & 3)) << 4));
  LAS unsigned char* dmaw = ldsl + wid * 1024;
  const int voff = r32 * 64 + (((2 * hi) ^ ((r32 >> 2) & 3)) << 4);
#define DMA(t, S) do { if (!(dry && ATT_VAR == 1)) { LAS unsigned char* d_ = dmaw + (S) * STG; \
    const unsigned ko_ = kofs + (unsigned)(t) * (unsigned)(64 * DM), vo_ = vofs + (unsigned)(t) * 64u;     \
    __builtin_amdgcn_global_load_lds((const unsigned*)(Kh + ko_), (LAS unsigned*)d_, 16, 0, 0); \
    __builtin_amdgcn_global_load_lds((const unsigned*)(VTh + vo_), (LAS unsigned*)(d_ + VOFF), 16, 0, 0); } } while (0)
#define KST(S) (lds + (S) * STG)
#define VST(S) (lds + (S) * STG + VOFF)
#define RESC(a) do { if (__any((a) < 1.f)) { if (hi == 0) al_l[r32] = (a); asm volatile("s_waitcnt lgkmcnt(0)" ::: "memory"); \
    for (int r = 0; r < 16; ++r) { const float a_ = al_l[crow(r, hi)]; lacc[r] *= a_; for (int d = 0; d < 4; ++d) o[d][r] *= a_; } } } while (0)
#define BARRIER() do { if (!(dry && ATT_VAR == 6)) asm volatile("s_barrier" ::: "memory"); } while (0)
  f32x16 pA0, pA1, pB0, pB1; float alA, alB; i32x8 pa; const int NT = seq / 64; VRegs vr;
  DMA(0, 0); DMA(1, 1);
  asm volatile("s_waitcnt vmcnt(2)" ::: "memory"); __syncthreads();
  DMA(2, 2);
  qkt(pA0, pA1, KST(0), qr, r32, hi, csub, mneg); partialSM(pA0, pA1, m_reg, mneg, alA, true); for (int r = 0; r < 16; ++r) pA1[r] = __builtin_amdgcn_exp2f(pA1[r]);
#define STEP(u, SK, SV, SD, PN0, PN1, ALN, PC0, PC1, VMC, DMACOND) do { \
    asm volatile("s_waitcnt vmcnt(" #VMC ")" ::: "memory"); BARRIER(); if (DMACOND) DMA((u) + 2, SD); \
    SBAR(); pv_load<0>(vr, VST(SV), voff); if (!(dry && (ATT_VAR == 4 || ATT_VAR == 8))) qkt(PN0, PN1, KST(SK), qr, r32, hi, csub, mneg); SBAR(); pv_load<1>(vr, VST(SV), voff); \
    finishSM(PC0, PC1, pa, dry ? ATT_VAR : 0); SBAR(); \
    if (!(dry && (ATT_VAR == 3 || ATT_VAR == 8))) pv_mma(o, lacc, ones, vr, pa); partialSM_nb(PN0, PN1, m_reg, mneg, ALN, dry ? ATT_VAR : 0); \
    RESC(ALN); } while (0)
  int u = 1;
  for (; u + 3 < NT; u += 4) {
    STEP(u,     1, 0, 3, pB0, pB1, alB, pA0, pA1, 2, true);
    STEP(u + 1, 2, 1, 0, pA0, pA1, alA, pB0, pB1, 2, true);
    STEP(u + 2, 3, 2, 1, pB0, pB1, alB, pA0, pA1, 2, true);
    STEP(u + 3, 0, 3, 2, pA0, pA1, alA, pB0, pB1, 2, true);
  }
  STEP(u,     1, 0, 3, pB0, pB1, alB, pA0, pA1, 2, true);
  STEP(u + 1, 2, 1, 0, pA0, pA1, alA, pB0, pB1, 2, false);
  STEP(u + 2, 3, 2, 1, pB0, pB1, alB, pA0, pA1, 0, false);
  pv_load<0>(vr, VST(3), voff); pv_load<1>(vr, VST(3), voff); finishSM(pB0, pB1, pa); SBAR();
  pv_mma(o, lacc, ones, vr, pa);
  float rli[16];
#pragma unroll
  for (int r = 0; r < 16; ++r) rli[r] = __builtin_amdgcn_rcpf(lacc[r]);
  __syncthreads();
  float* Cs = (float*)lds;
  if (csub == 1) {
#pragma unroll
    for (int r = 0; r < 16; ++r) { const float f = rli[r] * lam; float* cp = Cs + (wq * 32 + crow(r, hi)) * 128 + r32;
#pragma unroll
      for (int d0 = 0; d0 < 4; ++d0) cp[d0 * 32] = o[d0][r] * f; }
  }
  __syncthreads();
  if (csub == 0) {
    float gs[4];
#pragma unroll
    for (int d0 = 0; d0 < 4; ++d0) gs[d0] = gsub[d0 * 32 + r32] * oscale;
#pragma unroll
    for (int r = 0; r < 16; ++r) { const int row = wq * 32 + crow(r, hi); const float* cp = Cs + row * 128 + r32; float v[4]; float ss = 0.f;
#pragma unroll
      for (int d0 = 0; d0 < 4; ++d0) { v[d0] = o[d0][r] * rli[r] - cp[d0 * 32]; ss += v[d0] * v[d0]; }
      ss = dpp_add<0xB1, 0xF>(ss); ss = dpp_add<0x4E, 0xF>(ss); ss = dpp_add<0x141, 0xF>(ss); ss = dpp_add<0x140, 0xF>(ss);
      { auto rr = __builtin_amdgcn_permlane16_swap(__float_as_uint(ss), __float_as_uint(ss), false, false); ss = __uint_as_float(rr[0]) + __uint_as_float(rr[1]); }
      const float rstd = 1.f / sqrtf(ss * (1.f / 128.f) + EPSN);
      unsigned char* op = Ob + (size_t)row * DM + r32;
#pragma unroll
      for (int d0 = 0; d0 < 4; ++d0) { const float x = v[d0] * rstd * gs[d0]; const unsigned ov = (unsigned)__builtin_amdgcn_cvt_pk_fp8_f32(x, x, 0, false); if (!dry) op[d0 * 32] = (unsigned char)ov; else asm volatile("" :: "v"(ov)); } }
  }
  __syncthreads();
#undef DMA
#undef KST
#undef VST
#undef STEP
#undef BARRIER
#undef RESC
}
}

__device__ __forceinline__ void scan_unit(const Frame& F, KArgs A, int l, int b, int blk, bool dry = false) {
    int tid = F.tid; asm volatile("" : "+v"(tid));
    const int lane = tid & 63, w = F.wave, fr = lane & 15, q4 = lane >> 4, tr = tid >> 4, cg = tid & 15;
    LAS unsigned char* Us = F.lds;
    LAS float* Hs = (LAS float*)(F.lds + 16384);
    const size_t rowb = (size_t)b * PBR;
    const size_t coff = rowb * DM + (size_t)blk * 128 + cg * 8;
    const bf16_t* rxp = (const bf16_t*)(F.ws + WS_PARTS) + coff;
    bf16_t* rgp = (bf16_t*)(F.ws + WS_PARTS) + 4 * PART_ELEMS + coff;
    bf16_t* hfp = (bf16_t*)(F.ws + WS_HA) + coff;
    float zs_ = 0.f; asm volatile("" : "+v"(zs_));
    float cwv[4][8], cbv[8];
#pragma unroll
    for (int i = 0; i < 8; ++i) { cbv[i] = A->in[I_CONVB][l * DM + blk * 128 + cg * 8 + i];
#pragma unroll
        for (int j = 0; j < 4; ++j) cwv[j][i] = A->in[I_CONVW][(l * 4 + j) * DM + blk * 128 + cg * 8 + i]; }
    for (int dir = 0; dir < 2; ++dir) {
        const bf16_t* Wt = (const bf16_t*)(F.ws + WS_WMIX + (size_t)l * WMIX_LAYER + WM_LRU) + (size_t)(dir * 8 + blk) * 256 * 128;
        bf16x8 bfa[4], bfx[4];
#pragma unroll
        for (int kk = 0; kk < 4; ++kk) { bfa[kk] = *(const bf16x8*)(Wt + (size_t)(16 * w + fr) * 128 + kk * 32 + q4 * 8); bfx[kk] = *(const bf16x8*)(Wt + (size_t)(128 + 16 * w + fr) * 128 + kk * 32 + q4 * 8); }
        const int pidx = (l * 2 + dir) * DM + blk * 128 + 16 * w + fr;
        const float ba = A->in[I_LBA][pidx], bx = A->in[I_LBX][pidx], lamv = A->in[I_LLAM][pidx];
        const float cl2 = -8.f * log1pf(expf(-lamv)) * 1.4426950408889634f;
        float h = 0.f;
        u32x4 rxq[2][4], hfq[2], rgq[2];
#define STEP_GEOM(n, T0, LSEG, SEGB) do { const bool sc_ = (n) < 4; const int ci_ = sc_ ? (n) : (n) - 4, nch_ = sc_ ? 4 : 64; T0 = 64 * (dir ? nch_ - 1 - ci_ : ci_); LSEG = sc_ ? LC : SEQ; SEGB = sc_ ? 0 : LC; } while (0)
#define LOAD_RX(n) do { int t0_, ls_, sb_; STEP_GEOM(n, t0_, ls_, sb_); \
        _Pragma("unroll") for (int tk = 0; tk < 2; ++tk) _Pragma("unroll") for (int j = 0; j < 4; ++j) { const int trow = t0_ + tr + 32 * tk + j - 2; \
            const int tc_ = (trow >= 0 && trow < ls_) ? trow : t0_ + tr + 32 * tk;     \
            rxq[tk][j] = *(const u32x4*)(rxp + (size_t)(sb_ + tc_) * DM); } } while (0)
#define LOAD_HG(n) do { int t0_, ls_, sb_; STEP_GEOM(n, t0_, ls_, sb_); \
        _Pragma("unroll") for (int tk = 0; tk < 2; ++tk) { const size_t ro = (size_t)(sb_ + t0_ + tr + 32 * tk) * DM; \
            hfq[tk] = __builtin_nontemporal_load((const u32x4*)(hfp + ro)); rgq[tk] = *(const u32x4*)(rgp + ro); } } while (0)
        LOAD_RX(0); if (dir) LOAD_HG(0);
        for (int n = 0; n < 68; ++n) {
            int t0, lseg, segb; STEP_GEOM(n, t0, lseg, segb);
#pragma unroll
            for (int tk = 0; tk < 2; ++tk) {
                float u[8];
#pragma unroll
                for (int i = 0; i < 8; ++i) u[i] = cbv[i];
#pragma unroll
                for (int j = 0; j < 4; ++j) { u32x4 x = rxq[tk][j];
                    { const int trow = t0 + tr + 32 * tk + j - 2; const unsigned mk = (trow >= 0 && trow < lseg) ? 0xffffffffu : 0u; x.x &= mk; x.y &= mk; x.z &= mk; x.w &= mk; }
                    u[0] += bflo(x.x) * cwv[j][0]; u[1] += bfhi(x.x) * cwv[j][1]; u[2] += bflo(x.y) * cwv[j][2]; u[3] += bfhi(x.y) * cwv[j][3];
                    u[4] += bflo(x.z) * cwv[j][4]; u[5] += bfhi(x.z) * cwv[j][5]; u[6] += bflo(x.w) * cwv[j][6]; u[7] += bfhi(x.w) * cwv[j][7]; }
                const int tl = tr + 32 * tk, tau = dir ? 63 - tl : tl;
                u32x4 wv; wv.x = pk2(u[0], u[1]); wv.y = pk2(u[2], u[3]); wv.z = pk2(u[4], u[5]); wv.w = pk2(u[6], u[7]);
                *(LAS u32x4*)(Us + KSWZ(tau, cg * 16)) = wv;
            }
            if (n + 1 < 68) LOAD_RX(n + 1);
            __syncthreads();
            f32x4 Ga[4], Gx[4];
#pragma unroll
            for (int tt = 0; tt < 4; ++tt) { Ga[tt] = (f32x4){zs_, zs_, zs_, zs_}; Gx[tt] = (f32x4){zs_, zs_, zs_, zs_};
#pragma unroll
                for (int kk = 0; kk < 4; ++kk) { const bf16x8 af = *(const LAS bf16x8*)(Us + KSWZ(16 * tt + fr, 64 * kk + 16 * q4));
                    Ga[tt] = __builtin_amdgcn_mfma_f32_16x16x32_bf16(af, bfa[kk], Ga[tt], 0, 0, 0);
                    Gx[tt] = __builtin_amdgcn_mfma_f32_16x16x32_bf16(af, bfx[kk], Gx[tt], 0, 0, 0); } }
#pragma unroll
            for (int tt = 0; tt < 4; ++tt) {
                float Al[4], Bl[4]; float Ac = 1.f, Bc = 0.f;
#pragma unroll
                for (int rg_ = 0; rg_ < 4; ++rg_) { const int tau = 16 * tt + 4 * q4 + rg_;
                    const float uu = __builtin_bit_cast(float, (unsigned)(*(const LAS unsigned short*)(Us + KSWZ(tau, (16 * w + fr) * 2))) << 16);
                    const float r = fast_sigmoid(Ga[tt][rg_] + ba), av = __builtin_amdgcn_exp2f(cl2 * r), ig = fast_sigmoid(Gx[tt][rg_] + bx);
                    const float bv = __builtin_amdgcn_sqrtf(fmaxf(1.f - av * av, 0.f)) * ig * uu;
                    Bc = av * Bc + bv; Ac = av * Ac; Al[rg_] = Ac; Bl[rg_] = Bc; }
                { const float A1 = __shfl_up(Ac, 16), B1 = __shfl_up(Bc, 16); if (q4 >= 1) { Bc = Ac * B1 + Bc; Ac = Ac * A1; } }
                { const float A2 = __shfl_up(Ac, 32), B2 = __shfl_up(Bc, 32); if (q4 >= 2) { Bc = Ac * B2 + Bc; Ac = Ac * A2; } }
                float Ae = __shfl_up(Ac, 16), Be = __shfl_up(Bc, 16); if (q4 == 0) { Ae = 1.f; Be = 0.f; }
                const float hin = Ae * h + Be;
                const float At = __shfl(Ac, 48 + fr), Bt = __shfl(Bc, 48 + fr);
#pragma unroll
                for (int rg_ = 0; rg_ < 4; ++rg_) Hs[(16 * tt + 4 * q4 + rg_) * 132 + 16 * w + fr] = Al[rg_] * hin + Bl[rg_];
                h = At * h + Bt;
            }
            __syncthreads();
#pragma unroll
            for (int tk = 0; tk < 2; ++tk) { const int tl = tr + 32 * tk, tau = dir ? 63 - tl : tl; const size_t ro = (size_t)(segb + t0 + tl) * DM;
                const f32x4 h0 = *(const LAS f32x4*)(Hs + tau * 132 + cg * 8), h1 = *(const LAS f32x4*)(Hs + tau * 132 + cg * 8 + 4);
                u32x4 o;
                if (dir == 0) { o.x = pk2(h0[0], h0[1]); o.y = pk2(h0[2], h0[3]); o.z = pk2(h1[0], h1[1]); o.w = pk2(h1[2], h1[3]); *(u32x4*)(hfp + ro) = o; }
                else { const u32x4 f = hfq[tk], g = rgq[tk];
                    o.x = pk2((h0[0] + bflo(f.x)) * bflo(g.x), (h0[1] + bfhi(f.x)) * bfhi(g.x)); o.y = pk2((h0[2] + bflo(f.y)) * bflo(g.y), (h0[3] + bfhi(f.y)) * bfhi(g.y));
                    o.z = pk2((h1[0] + bflo(f.z)) * bflo(g.z), (h1[1] + bfhi(f.z)) * bfhi(g.z)); o.w = pk2((h1[2] + bflo(f.w)) * bflo(g.w), (h1[3] + bfhi(f.w)) * bfhi(g.w));
                    if (!dry) *(u32x4*)(rgp + ro) = o; }
            }
            if (dir && n + 1 < 68) LOAD_HG(n + 1);
        }
        VM_WAIT(); __syncthreads();
#undef STEP_GEOM
#undef LOAD_RX
#undef LOAD_HG
    }
}

#ifndef PH_MASK
#define PH_MASK 0xFFF
#endif
#define PH_ON(k) (((PH_MASK) >> (k)) & 1)
#ifndef LAYER_UNROLL
#define LAYER_UNROLL 1
#endif
#ifndef G1_PLAIN_PROBE
#define G1_PLAIN_PROBE 0
#endif
#ifndef R1_VAR
#define R1_VAR 0
#endif
#ifndef A1_DRY
#define A1_DRY 0
#endif
#ifndef P0_SKIP_PROBE
#define P0_SKIP_PROBE 0
#endif
#ifndef E2_NOSTORE_PROBE
#define E2_NOSTORE_PROBE 0
#endif
#ifndef REP_MASK
#define REP_MASK 0
#endif
#define REPS(k) ((((REP_MASK) >> (k)) & 1) ? 2 : 1)
#define REPBAR(k, r) do { if ((r) + 1 < REPS(k)) { KArgs Ab = kargs(); XcdBarrier bar; bar.bar = (unsigned*)(Ab->ws + WS_CTL) + CW_BAR; bar.x = xb_xcc_id(); bar.st = (volatile LAS unsigned*)((LAS unsigned char*)lds + MISC_OFF) + 8; xcd_barrier(bar); } } while (0)
__device__ __forceinline__ Frame make_frame(KArgs A, unsigned char* ldsg, int wave0) {
    Frame F;
    F.lds = (LAS unsigned char*)ldsg; F.ldsg = ldsg;
    F.MISC = (volatile LAS unsigned*)(F.lds + MISC_OFF);
    { unsigned m_ = ~0u; asm volatile("" : "+s"(m_));
      F.tid = wave0 * 64 + (int)__builtin_amdgcn_mbcnt_hi(m_, __builtin_amdgcn_mbcnt_lo(m_, 0u)); asm volatile("" : "+v"(F.tid)); } F.lane = F.tid & 63; F.wave = __builtin_amdgcn_readfirstlane(F.tid >> 6);
    F.G = gridDim.x; { const int bx = blockIdx.x; F.vcu = (F.G % 8 == 0) ? (bx % 8) * (F.G / 8) + bx / 8 : bx; }
    F.ws = A->ws; F.ctl = (unsigned*)(F.ws + WS_CTL); F.out = A->out;
    return F;
}
#ifndef DBG_STOP_AFTER
#define DBG_STOP_AFTER 1000
#endif
#define IN(k) (lo <= (k) && (k) < hi && ((k) <= DBG_STOP_AFTER || (k) == N_PHASES - 1))
#define MKF() asm volatile("; PHASE_MARK" ::: "memory"); KArgs A = kargs(); const Frame F = make_frame(A, lds, wave0)
#define SEAM(k) do { if (IN(k) && IN((k) + 1)) { KArgs Ab = kargs(); XcdBarrier bar; bar.bar = (unsigned*)(Ab->ws + WS_CTL) + CW_BAR; bar.x = xb_xcc_id(); \
        bar.st = (volatile LAS unsigned*)((LAS unsigned char*)lds + MISC_OFF) + 8; xcd_barrier(bar); } } while (0)

template <int l> __device__ __forceinline__ void layer_body(unsigned char* lds, const int lo, const int hi, const int wave0) {
        constexpr int pb = 1 + 9 * l;
        for (int rep_ = 0; rep_ < (l == 0 ? REPS(1) : 1); ++rep_) { if (PH_ON(1) && IN(pb + 0)) { MKF(); n1_phase(F, A, l); } if (l == 0) REPBAR(1, rep_); } SEAM(pb + 0);
        for (int rep_ = 0; rep_ < REPS(2); ++rep_) { if (PH_ON(2) && IN(pb + 1)) { MKF();
            unsigned char* wl = F.ws + WS_WMIX + (size_t)l * WMIX_LAYER;
            constexpr unsigned M8 = G1_F8_PARTS & 0x7f, M16 = ~G1_F8_PARTS & 0x7f; constexpr int NP8 = g1_np(M8), NP16 = g1_np(M16);
            const int plain = (REPS(2) == 2 && rep_ == 0 && G1_PLAIN_PROBE) ? 1 : 0;
            if (NP8) {
                pg8::Gemm g{(const bf16_t*)(F.ws + WS_HA8), (const bf16_t*)(wl + WM_WIN), DM / 2}; OrderG1 S{F.G, (int)blockIdx.x, NP8, g1_plist(M8), true};
                EpiG1 E{(bf16_t*)(F.ws + WS_PARTS), (const float*)(F.ws + WS_COS), (const float*)(F.ws + WS_SIN), F.ws + WS_GATES, plain, 1.f / 32.f};
                pg8::gemm_phase<EpiG1, OrderG1, true, true, true>(F.lds, g, S, E, F.tid);
            }
            if (NP8 && NP16) __syncthreads();
            if (NP16) {
                const int G = F.G, rem8 = (NTILE * 4 * NP8) % G & ~7, c2 = ((int)blockIdx.x - rem8 + G) % G;
                pg8::Gemm g{(const bf16_t*)(F.ws + WS_HA), (const bf16_t*)(wl + WM_WIN), DM}; OrderG1 S{F.G, (F.G % 8 == 0) ? c2 : (int)blockIdx.x, NP16, g1_plist(M16), false};
                EpiG1 E{(bf16_t*)(F.ws + WS_PARTS), (const float*)(F.ws + WS_COS), (const float*)(F.ws + WS_SIN), F.ws + WS_GATES, plain, 1.f};
                pg8::gemm_phase<EpiG1, OrderG1, true, true, false>(F.lds, g, S, E, F.tid);
            }
        } REPBAR(2, rep_); } SEAM(pb + 1);
        if ((PH_ON(3) || PH_ON(4)) && IN(pb + 2)) { MKF();
            bf16_t* const parts = (bf16_t*)(F.ws + WS_PARTS);
            const int total = 64 + 2048 + 512 + (l == 0 ? NB * 8 * 2 : 0);
            const float lam = __builtin_bit_cast(float, __builtin_amdgcn_readfirstlane(ld_dev((const float*)(F.ws + WS_LAM) + l * 2))), oscale = __builtin_bit_cast(float, __builtin_amdgcn_readfirstlane(ld_dev((const float*)(F.ws + WS_LAM) + l * 2 + 1)));
            for (int pass = (A1_DRY ? 0 : 1); pass < 2; ++pass) {
            const bool dry = (pass == 0);
            for (;;) {
                if (F.tid == 0) F.MISC[12] = __hip_atomic_fetch_add(F.ctl + CW_QUEUE + 64 * (l + (dry ? 2 : 0)), 1u, __ATOMIC_RELAXED, __HIP_MEMORY_SCOPE_AGENT);
                __syncthreads();
                const int id = __builtin_amdgcn_readfirstlane((int)F.MISC[12]);
                __syncthreads();
                if (id >= total) break;
                if (id < 64) { if (PH_ON(3) && (!dry || (A1_DRY & 1))) scan_unit(F, A, l, id >> 3, id & 7, dry); continue; }
                if (!PH_ON(4) || (dry && !(A1_DRY & 2))) continue;
                int a = id - 64, b, h, r0, seq;
                if (a < 2048) { const int qb = a & 31; h = (a >> 5) & 7; b = a >> 8; r0 = b * PBR + LC + qb * 128; seq = PBR; }
                else if (a < 2048 + 512) { if (!dry) expert_conv_unit(F, A, l, a - 2048); continue; }
                else { a -= 2048 + 512; const int qb = a & 1; h = (a >> 1) & 7; b = a >> 4; r0 = b * PBR + qb * 128; seq = LC; }
                unsigned char* Ob = (unsigned char*)(parts + 3 * PART_ELEMS) + (size_t)r0 * DM + h * 128;
                const unsigned char* Kh = (const unsigned char*)(parts + 1 * PART_ELEMS) + (size_t)b * PBR * DM + h * 128;
                const unsigned char* Qb = (const unsigned char*)(parts + 1 * PART_ELEMS) + GATE_BYTES + (size_t)r0 * DM + h * 128;
                const unsigned char* Vh = (const unsigned char*)(parts + 2 * PART_ELEMS) + (size_t)(b * DM + h * 128) * (68 * 64);
                att::attn_unit(Qb, Kh, Vh, Ob, seq, lam, oscale, A->in[I_GSUB] + l * 128, (char*)F.ldsg, F.lds, F.tid, dry);
            }
            if (dry) { VM_WAIT(); __syncthreads(); }
            }
        } SEAM(pb + 2);
        for (int rep_ = 0; rep_ < REPS(5); ++rep_) { if (PH_ON(5) && IN(pb + 3)) { MKF();
            unsigned char* wl = F.ws + WS_WMIX + (size_t)l * WMIX_LAYER; bf16_t* const parts = (bf16_t*)(F.ws + WS_PARTS);
            { pg8::Gemm g{parts, (const bf16_t*)(wl + WM_WR), DM}; OrderG2 S{F.G, F.vcu, l == NLAYER - 1, 0, false}; EpiG2 E{parts, F.ws + WS_GATES, 1.f / 255.f, F.ws + WS_HA8};
              pg8::gemm_phase<EpiG2, OrderG2, true, true>(F.lds, g, S, E, F.tid); }
            __syncthreads();
            { pg8::Gemm g{parts, (const bf16_t*)(wl + WM_WR), DM / 2}; OrderG2 S{F.G, F.vcu, l == NLAYER - 1, 1, true}; EpiG2 E{parts, F.ws + WS_GATES, 1.f / (255.f * 32.f), F.ws + WS_HA8};
              pg8::gemm_phase<EpiG2, OrderG2, true, true, true>(F.lds, g, S, E, F.tid); }
        } REPBAR(5, rep_); } SEAM(pb + 3);
        for (int rep_ = 0; rep_ < REPS(6); ++rep_) { if (PH_ON(6) && IN(pb + 4)) { MKF();
            unsigned char* wl = F.ws + WS_WMIX + (size_t)l * WMIX_LAYER; bf16_t* const parts = (bf16_t*)(F.ws + WS_PARTS);
            pg8::Gemm g{G3_F8 ? (const bf16_t*)(F.ws + WS_HA8) : parts, (const bf16_t*)(wl + WM_WO), G3_F8 ? DM / 2 : DM}; OrderG3 S{F.G, F.vcu, l == NLAYER - 1};
            EpiG3 E{F.ws, (const float*)(F.ws + WS_MODV) + (size_t)l * NCOND * MODW, (G3_F8 ? 1.f / 32.f : 1.f) / (float)REPS(6)};
            pg8::gemm_phase<EpiG3, OrderG3, true, true, G3_F8 != 0>(F.lds, g, S, E, F.tid);
        } REPBAR(6, rep_); } SEAM(pb + 4);
        for (int rep_ = 0; rep_ < REPS(7); ++rep_) { if (PH_ON(7) && IN(pb + 5)) { MKF(); r1_phase(F, A, l, (REPS(7) == 2 && rep_ == 0) ? R1_VAR : 0); } REPBAR(7, rep_); } SEAM(pb + 5);
        for (int rep_ = 0; rep_ < REPS(8); ++rep_) { if (PH_ON(8) && IN(pb + 6)) { MKF(); r2_phase(F, A, l); } REPBAR(8, rep_); } SEAM(pb + 6);
        for (int rep_ = 0; rep_ < REPS(9); ++rep_) { if (PH_ON(9) && IN(pb + 7)) { MKF();
            LAS int* tabL = (LAS int*)(F.lds + TAB_OFF);
            for (int i = F.tid; i < 320; i += NWAVES * 64) tabL[i] = ((const int*)(F.ws + WS_BLKTAB))[i];
            __syncthreads();
            const int nblk = __builtin_amdgcn_readfirstlane(tabL[300]);
            pg8::Gemm g{(const bf16_t*)F.ws, (const bf16_t*)F.ws, DM / 2};
            OrderE S{F.G, F.vcu, nblk, 8, tabL, (int)(WS_XB / F8_TILE), (int)(WS_W13 / F8_TILE)}; EpiE1 E{F.ws + WS_ACT};
            pg8::gemm_phase<EpiE1, OrderE, true, true, true>(F.lds, g, S, E, F.tid);
        } REPBAR(9, rep_); } SEAM(pb + 7);
        for (int rep_ = 0; rep_ < REPS(10); ++rep_) { if (PH_ON(10) && IN(pb + 8)) { MKF();
            LAS int* tabL = (LAS int*)(F.lds + TAB_OFF);
            for (int i = F.tid; i < 320; i += NWAVES * 64) tabL[i] = ((const int*)(F.ws + WS_BLKTAB))[i];
            __syncthreads();
            const int nblk = __builtin_amdgcn_readfirstlane(tabL[300]);
            pg8::Gemm g{(const bf16_t*)F.ws, (const bf16_t*)F.ws, DM / 2};
            OrderE S{F.G, F.vcu, nblk, 4, tabL, (int)(WS_ACT / F8_TILE), (int)(WS_W2 / F8_TILE)}; EpiE2 E{F.ws + WS_XB, (REPS(10) == 2 && rep_ == 0 && E2_NOSTORE_PROBE) ? 1 : 0};
            pg8::gemm_phase<EpiE2, OrderE, true, true, true>(F.lds, g, S, E, F.tid);
        } REPBAR(10, rep_); } SEAM(pb + 8);
    }
__global__ void __launch_bounds__(NWAVES * 64, 2) fwd_kernel(Args args_in_kernarg_segment) {
    extern __shared__ __attribute__((aligned(16))) unsigned char lds[];
    for (int u = threadIdx.x; u < (LDS_BYTES - LDSCTL_OFF) / 4; u += NWAVES * 64) ((LAS unsigned*)((LAS unsigned char*)lds + LDSCTL_OFF))[u] = 0u;
    __syncthreads();
    int lo, hi; const int wave0 = __builtin_amdgcn_readfirstlane((int)threadIdx.x >> 6);
    { KArgs A = kargs(); lo = A->ph_lo; hi = A->ph_hi; (void)xcd_barrier_post((unsigned*)(A->ws + WS_CTL) + CW_BAR, (volatile LAS unsigned*)((LAS unsigned char*)lds + MISC_OFF) + 8); }
    for (int rep_ = 0; rep_ < REPS(0); ++rep_) { if (PH_ON(0) && IN(0)) { MKF(); p0_phase(F, A, (REPS(0) == 2 && rep_ == 0) ? P0_SKIP_PROBE : 0); } REPBAR(0, rep_); } SEAM(0);
    layer_body<0>(lds, lo, hi, wave0);
    layer_body<1>(lds, lo, hi, wave0);
    if (PH_ON(11) && IN(N_PHASES - 1)) { MKF(); final_phase(F, A); }
#undef IN
#undef SEAM
#undef MKF
}


#if MK_VERIFY
constexpr int CW_VFLAG = 12000;
__device__ __forceinline__ float vbf(float x) { return __builtin_bit_cast(float, f2bf(x) << 16); }
__global__ void verify_r1(Args a, int l) {
    const int lane = threadIdx.x & 63, gw = (blockIdx.x * blockDim.x + threadIdx.x) >> 6;
    const int R = (gw * 131 + 7) % TR; const int b = R / PBR, p = R - b * PBR; const int cond = p < LC ? 8 : b;
    const float* xp = p < LC ? (const float*)(a.ws + WS_XC) + ((size_t)b * LC + p) * DM : a.out + ((size_t)b * SEQ + (p - LC)) * DM;
    float ss = 0.f; for (int k = lane; k < DM; k += 64) ss += xp[k] * xp[k];
    ss = wave_sum(ss); const float rstd = 1.f / sqrtf(ss / DM + EPSN);
    const float* md = (const float*)(a.ws + WS_MODV) + ((size_t)l * NCOND + cond) * MODW;
    float lg[16]; for (int e = 0; e < 16; ++e) lg[e] = 0.f;
    for (int k = lane; k < DM; k += 64) { const float h = xp[k] * rstd * a.in[I_GN2][l * DM + k] * (1.f + md[4 * DM + k]) + md[3 * DM + k];
        for (int e = 0; e < 16; ++e) lg[e] += h * a.in[I_WROUT][k * 16 + e]; }
    for (int e = 0; e < 16; ++e) lg[e] = wave_sum(lg[e]) + a.in[I_BROUT][e];
    int best = 0; for (int e = 1; e < 16; ++e) if (lg[e] > lg[best]) best = e;
    int e2 = -1; for (int e = 0; e < 16; ++e) if ((e >> 2) == (best >> 2) && e != best && (e2 < 0 || lg[e] > lg[e2])) e2 = e;
    float m1 = 1e30f; for (int e = 0; e < 16; ++e) if (e != best) m1 = fminf(m1, lg[best] - lg[e]);
    float m2 = 1e30f; for (int e = 0; e < 16; ++e) if ((e >> 2) == (best >> 2) && e != best && e != e2) m2 = fminf(m2, lg[e2] - lg[e]);
    const u32x4 info = ((const u32x4*)(a.ws + WS_TOKINFO))[R];
    const float g1 = 1.f / (1.f + expf(lg[e2] - lg[best]));
    unsigned* fl = (unsigned*)(a.ws + WS_CTL) + CW_VFLAG;
    if (lane == 0 && m1 > 1e-3f && m2 > 1e-3f) {
        if ((int)(info.x & 255u) != best) atomicAdd(fl + 8, 1u);
        if ((int)((info.x >> 8) & 255u) != e2) atomicAdd(fl + 9, 1u);
        if (fabsf(((const float*)(a.ws + WS_TOKGATE))[R] - g1) > 1e-3f) atomicAdd(fl + 10, 1u);
        if ((info.x & 255u) == 255u) atomicAdd(fl + 11, 1u);
        if (info.w == 0u) atomicAdd(fl + 15, 1u); if (info.w != 0u && info.w < 65536u) atomicAdd(fl + 16, 1u); if (info.w == info.z) atomicAdd(fl + 17, 1u); if (info.w == info.y) atomicAdd(fl + 18, 1u);
        { const float gw_ = __builtin_bit_cast(float, info.w); if (fabsf(gw_) < 1e-6f) atomicAdd(fl + 12, 1u); if (!(gw_ >= 0.5f && gw_ <= 1.f)) atomicAdd(fl + 13, 1u); if (fabsf(gw_ - (1.f - g1)) < 1e-3f) atomicAdd(fl + 14, 1u); }
        if ((int)(info.x & 255u) != best || (int)((info.x >> 8) & 255u) != e2 || fabsf(__builtin_bit_cast(float, info.w) - g1) > 1e-3f) atomicAdd(fl + 0, 1u);
    }
}
__global__ void verify_r2(Args a) {
    const int lane = threadIdx.x & 63, gw = (blockIdx.x * blockDim.x + threadIdx.x) >> 6;
    const int R = (gw * 131 + 7) % TR;
    const u32x4 info = ((const u32x4*)(a.ws + WS_TOKINFO))[R]; if ((info.x & 255u) == 255u) return;
    const u32x4 sl = ((const u32x4*)(a.ws + WS_TOKC))[R]; const int* tab = (const int*)(a.ws + WS_BLKTAB);
    bool bad = false; const int nblk = tab[300];
    if ((int)(sl.x >> 8) >= nblk || (int)(sl.y >> 8) >= nblk || nblk > MAXBLK) bad = true;
    else { if (tab[sl.x >> 8] != (int)(info.x & 255u) || tab[sl.y >> 8] != (int)((info.x >> 8) & 255u)) bad = true;
        const unsigned* h = (const unsigned*)((const bf16_t*)(a.ws + WS_HA) + (size_t)R * DM); const unsigned* x1 = (const unsigned*)((const bf16_t*)(a.ws + WS_XB) + (size_t)sl.x * DM); const unsigned* x2 = (const unsigned*)((const bf16_t*)(a.ws + WS_XB) + (size_t)sl.y * DM);
        for (int k = lane; k < DM / 2; k += 64) if (h[k] != x1[k] || h[k] != x2[k]) bad = true; }
    if (__any(bad) && lane == 0) atomicAdd((unsigned*)(a.ws + WS_CTL) + CW_VFLAG + 1, 1u);
}
__global__ void verify_e1(Args a, int l) {
    const int lane = threadIdx.x & 63, gw = (blockIdx.x * blockDim.x + threadIdx.x) >> 6;
    const int R = (gw * 131 + 7) % TR;
    const u32x4 info = ((const u32x4*)(a.ws + WS_TOKINFO))[R]; if ((info.x & 255u) == 255u) return;
    const u32x4 sl = ((const u32x4*)(a.ws + WS_TOKC))[R];
    const unsigned slot = (gw & 1) ? sl.y : sl.x; const int e = (gw & 1) ? (int)((info.x >> 8) & 255u) : (int)(info.x & 255u);
    const int n = ((gw * 37) % 16) * 64 + lane;
    const bf16_t* xb = (const bf16_t*)(a.ws + WS_XB) + (size_t)slot * DM;
    const float* w1 = a.in[I_WE1] + ((size_t)l * NEXP + e) * DM * DM, *w3 = a.in[I_WE3] + ((size_t)l * NEXP + e) * DM * DM;
    float s1 = 0.f, s3 = 0.f;
    for (int k = 0; k < DM; ++k) { const float x = __builtin_bit_cast(float, (unsigned)xb[k] << 16); s1 += x * vbf(w1[(size_t)k * DM + n]); s3 += x * vbf(w3[(size_t)k * DM + n]); }
    const float ref = s1 / (1.f + expf(-s1)) * s3;
    const float got = __builtin_bit_cast(float, (unsigned)((const bf16_t*)(a.ws + WS_ACT))[(size_t)slot * DM + n] << 16);
    const bool bad = !(fabsf(got - ref) <= 0.03f * fabsf(ref) + 0.03f);
    if (__any(bad) && lane == 0) atomicAdd((unsigned*)(a.ws + WS_CTL) + CW_VFLAG + 2, 1u);
}
__global__ void verify_e2(Args a, int l) {
    const int lane = threadIdx.x & 63, gw = (blockIdx.x * blockDim.x + threadIdx.x) >> 6;
    const int R = (gw * 131 + 7) % TR;
    const u32x4 info = ((const u32x4*)(a.ws + WS_TOKINFO))[R]; if ((info.x & 255u) == 255u) return;
    const u32x4 sl = ((const u32x4*)(a.ws + WS_TOKC))[R];
    const unsigned slot = (gw & 1) ? sl.y : sl.x; const int e = (gw & 1) ? (int)((info.x >> 8) & 255u) : (int)(info.x & 255u);
    const int n = ((gw * 37) % 16) * 64 + lane;
    const bf16_t* ac = (const bf16_t*)(a.ws + WS_ACT) + (size_t)slot * DM;
    const float* w2 = a.in[I_WE2] + ((size_t)l * NEXP + e) * DM * DM;
    float s = 0.f;
    for (int k = 0; k < DM; ++k) s += __builtin_bit_cast(float, (unsigned)ac[k] << 16) * vbf(w2[(size_t)k * DM + n]);
    const float got = __builtin_bit_cast(float, (unsigned)((const bf16_t*)(a.ws + WS_XB))[(size_t)slot * DM + n] << 16);
    const bool bad = !(fabsf(got - s) <= 0.03f * fabsf(s) + 0.03f);
    if (__any(bad) && lane == 0) atomicAdd((unsigned*)(a.ws + WS_CTL) + CW_VFLAG + 3, 1u);
}
__global__ void verify_encode(Args a) {
    const unsigned* f = (const unsigned*)(a.ws + WS_CTL) + CW_VFLAG;
    const unsigned cnt = f[MK_VCHECK];
    if (cnt == 0u) return;
    const float s = 0.7f - 0.7f * fminf((float)cnt / 512.f, 1.f);
    for (size_t i = (size_t)blockIdx.x * blockDim.x + threadIdx.x; i < (size_t)NB * SEQ * DM; i += (size_t)gridDim.x * blockDim.x) a.out[i] *= s;
}
#endif
extern "C" void kernel_launch(void* const* d_in, const int* in_sizes, int n_in, void* d_out, int out_size, void* d_ws, size_t ws_size, hipStream_t stream) {
    static int grid = 0;
    if (grid == 0) {
        if (n_in != 27 || out_size != NB * SEQ * DM || ws_size < WS_END) { fprintf(stderr, "kernel_launch: shape mismatch (n_in %d out %d ws %zu, need ws >= %zu)\n", n_in, out_size, ws_size, (size_t)WS_END); grid = -1; return; }
        int dev = 0, cus = 0, per_cu = 0;
        if (hipGetDevice(&dev) != hipSuccess || hipDeviceGetAttribute(&cus, hipDeviceAttributeMultiprocessorCount, dev) != hipSuccess) { grid = -1; return; }
        if (hipFuncSetAttribute((const void*)fwd_kernel, hipFuncAttributeMaxDynamicSharedMemorySize, LDS_BYTES) != hipSuccess) { fprintf(stderr, "kernel_launch: hipFuncSetAttribute failed\n"); grid = -1; return; }
        if (hipOccupancyMaxActiveBlocksPerMultiprocessor(&per_cu, (const void*)fwd_kernel, NWAVES * 64, LDS_BYTES) != hipSuccess || per_cu < 1) { fprintf(stderr, "kernel_launch: occupancy query says %d\n", per_cu); }
        (void)hipGetLastError();
        grid = cus;
    }
    if (grid < 0) return;
    if (hipMemsetAsync((char*)d_ws + WS_CTL, 0, CTL_ZERO_BYTES, stream) != hipSuccess) return;
    Args a{};
    for (int i = 0; i < 27; ++i) a.in[i] = (const float*)d_in[i];
    a.out = (float*)d_out; a.ws = (unsigned char*)d_ws;
#if MK_PER_PHASE
    for (int k = 0; k < N_PHASES; ++k) { a.ph_lo = k; a.ph_hi = k + 1; hipLaunchKernelGGL(fwd_kernel, dim3(grid), dim3(NWAVES * 64), LDS_BYTES, stream, a);
#if MK_VERIFY
        const int vl = MK_VERIFY - 1, pb = 1 + 9 * vl;
        if (k == pb + 5) hipLaunchKernelGGL(verify_r1, dim3(128), dim3(256), 0, stream, a, vl);
        if (k == pb + 6) hipLaunchKernelGGL(verify_r2, dim3(128), dim3(256), 0, stream, a);
        if (k == pb + 7) hipLaunchKernelGGL(verify_e1, dim3(128), dim3(256), 0, stream, a, vl);
        if (k == pb + 8) hipLaunchKernelGGL(verify_e2, dim3(128), dim3(256), 0, stream, a, vl);
        if (k == N_PHASES - 1) hipLaunchKernelGGL(verify_encode, dim3(1024), dim3(256), 0, stream, a);
#endif
    }
#else
    a.ph_lo = 0; a.ph_hi = N_PHASES;
    hipLaunchKernelGGL(fwd_kernel, dim3(grid), dim3(NWAVES * 64), LDS_BYTES, stream, a);
#endif
    const hipError_t le = hipPeekAtLastError();
    if (le != hipSuccess) fprintf(stderr, "kernel_launch: launch failed: %s\n", hipGetErrorName(le));
}
```
